# Optimizing an MI355X kernel written in HIP

```python
import jax, jax.numpy as jnp
from jax import lax
import numpy as np

D_MODEL = 1024
BATCH = 8
SEQ = 2048
DEPTH = 4

N_MIXERS = 3
ROPE_THETA = 500000.0
NORM_EPS = 1e-6
BLOCK = 128
NEG_INF = -1e30
SWA_HEADS = 16
SWA_KV_HEADS = 4
SWA_HEAD_DIM = D_MODEL // SWA_HEADS
SWA_GROUP = SWA_HEADS // SWA_KV_HEADS
SWA_WINDOW = 128
SWA_ROT = SWA_HEAD_DIM // 4
RWKV_HEAD_DIM = 64
RWKV_HEADS = D_MODEL // RWKV_HEAD_DIM
RWKV_DECAY_LORA = 64
RWKV_A_LORA = 64
RWKV_GATE_LORA = 160
RWKV_GN_EPS = 64e-5
MLA_HEADS = 16
MLA_NOPE = 64
MLA_ROPE = 32
MLA_V = 64
MLA_Q_LORA = 384
MLA_KV_LORA = 256
FFN_DIM = 2816
CONV_WIDTH = 3

kernel_name = 'hybrid_swa_rwkv7_mla_convffn'

F32 = jnp.float32


def rms_norm(x, g):
    xf = x.astype(F32)
    y = xf * lax.rsqrt(jnp.mean(xf * xf, axis=-1, keepdims=True) + NORM_EPS)
    return (y * g.astype(F32)).astype(x.dtype)


def rope_tables(seq, rot_dim):
    inv = ROPE_THETA ** (-jnp.arange(0, rot_dim, 2, dtype=F32) / rot_dim)
    ang = jnp.arange(seq, dtype=F32)[:, None] * inv[None, :]
    return jnp.cos(ang), jnp.sin(ang)


def rope_slice(x, cos, sin, start):
    rot = 2 * cos.shape[-1]
    half = rot // 2
    x1 = x[..., start:start + half]
    x2 = x[..., start + half:start + rot]
    c = cos[None, :, None, :].astype(x.dtype)
    s = sin[None, :, None, :].astype(x.dtype)
    return jnp.concatenate([x[..., :start], x1 * c - x2 * s, x2 * c + x1 * s, x[..., start + rot:]], axis=-1)


def swa_mixer(h, w_qkv, q_gain, k_gain, sinks, w_o, cos, sin):
    b, s, _ = h.shape
    nb = s // BLOCK
    qd = SWA_HEADS * SWA_HEAD_DIM
    kd = SWA_KV_HEADS * SWA_HEAD_DIM
    qkv = h @ w_qkv
    q = qkv[..., :qd].reshape(b, s, SWA_HEADS, SWA_HEAD_DIM)
    k = qkv[..., qd:qd + kd].reshape(b, s, SWA_KV_HEADS, SWA_HEAD_DIM)
    v = qkv[..., qd + kd:].reshape(b, s, SWA_KV_HEADS, SWA_HEAD_DIM)
    q = rope_slice(rms_norm(q, q_gain), cos, sin, 0)
    k = rope_slice(rms_norm(k, k_gain), cos, sin, 0)
    q = q.reshape(b, nb, BLOCK, SWA_KV_HEADS, SWA_GROUP, SWA_HEAD_DIM)

    def band(t):
        tp = jnp.pad(t, ((0, 0), (BLOCK, BLOCK), (0, 0), (0, 0)))
        tp = tp.reshape(b, nb + 2, BLOCK, SWA_KV_HEADS, SWA_HEAD_DIM)
        return jnp.concatenate([tp[:, :-2], tp[:, 1:-1], tp[:, 2:]], axis=2)

    kb, vb = band(k), band(v)
    blk = jnp.arange(nb)[:, None]
    qpos = blk * BLOCK + jnp.arange(BLOCK)[None, :]
    kpos = (blk - 1) * BLOCK + jnp.arange(3 * BLOCK)[None, :]
    valid = ((kpos >= 0) & (kpos < s))[:, None, :]
    mask = (jnp.abs(qpos[:, :, None] - kpos[:, None, :]) <= SWA_WINDOW) & valid
    sink = sinks.astype(F32).reshape(SWA_KV_HEADS, SWA_GROUP)[None, :, :, None, None]
    scale = SWA_HEAD_DIM ** -0.5

    def attend(args):
        qb, kbb, vbb, mb = args
        sc = jnp.einsum('bqhgd,bkhd->bhgqk', qb, kbb).astype(F32) * scale
        sc = jnp.where(mb, sc, NEG_INF)
        m = jnp.maximum(jnp.max(sc, axis=-1, keepdims=True), sink)
        p = jnp.exp(sc - m)
        p = p / (jnp.sum(p, axis=-1, keepdims=True) + jnp.exp(sink - m))
        return jnp.einsum('bhgqk,bkhd->bqhgd', p.astype(vbb.dtype), vbb)

    o = lax.map(attend, (jnp.moveaxis(q, 1, 0), jnp.moveaxis(kb, 1, 0), jnp.moveaxis(vb, 1, 0), mask))
    o = jnp.moveaxis(o, 0, 1).reshape(b, s, qd)
    return o @ w_o


def wkv7_scan(r, w, k, v, a, bb, reverse):
    b, s, nh, n = r.shape
    seq = tuple(jnp.moveaxis(t, 1, 0) for t in (r, w, k, v, a, bb))

    def step(state, inp):
        r_t, w_t, k_t, v_t, a_t, b_t = inp
        sa = jnp.einsum('bhvk,bhk->bhv', state, a_t)
        state = state * w_t[:, :, None, :] + sa[..., None] * b_t[:, :, None, :] + v_t[..., None] * k_t[:, :, None, :]
        y = jnp.einsum('bhvk,bhk->bhv', state, r_t)
        return state, y

    s0 = jnp.zeros((b, nh, n, n), F32)
    _, y = lax.scan(step, s0, seq, reverse=reverse)
    return jnp.moveaxis(y, 0, 1)


def rwkv7_mixer(h, mu, w_r, w_k, w_v, w0, w1, w2, a0, a1, a2, g1, g2, k_k, k_a, r_k, lnx_w, lnx_b, w_o):
    b, s, d = h.shape
    hp = jnp.pad(h, ((0, 0), (1, 1), (0, 0)))
    xx = 0.5 * (hp[:, :-2] + hp[:, 2:]) - h
    xr = h + xx * mu[0]
    xw = h + xx * mu[1]
    xk = h + xx * mu[2]
    xv = h + xx * mu[3]
    xa = h + xx * mu[4]
    xg = h + xx * mu[5]
    r = xr @ w_r
    k = xk @ w_k
    v = xv @ w_v
    g = jax.nn.sigmoid(xg @ g1) @ g2

    def heads(t):
        return t.reshape(b, s, RWKV_HEADS, RWKV_HEAD_DIM)

    kk = heads(k * k_k).astype(F32)
    kk = kk / jnp.maximum(jnp.sqrt(jnp.sum(kk * kk, axis=-1, keepdims=True)), 1e-12)
    rf = heads(r).astype(F32)
    vf = heads(v).astype(F32)
    kf = k.astype(F32)
    rkf = r_k.astype(F32)

    def direction(dirn):
        wl = (w0[dirn] + jnp.tanh(xw @ w1[dirn]) @ w2[dirn]).astype(F32)
        decay = jnp.exp(-jnp.exp(-jax.nn.softplus(-wl) - 0.5))
        a = jax.nn.sigmoid((a0[dirn] + (xa @ a1[dirn]) @ a2[dirn]).astype(F32))
        kd = kf * (1.0 + (a - 1.0) * k_a.astype(F32))
        a, kd, decay = heads(a), heads(kd), heads(decay)
        y = wkv7_scan(rf, decay, kd, vf, -kk, kk * a, reverse=(dirn == 1))
        bonus = jnp.sum(rf * kd * rkf, axis=-1, keepdims=True) * vf
        return y, bonus

    y_f, bonus_f = direction(0)
    y_b, bonus_b = direction(1)
    y = y_f + y_b
    mean = jnp.mean(y, axis=-1, keepdims=True)
    var = jnp.mean(jnp.square(y - mean), axis=-1, keepdims=True)
    yn = ((y - mean) * lax.rsqrt(var + RWKV_GN_EPS)).reshape(b, s, d) * lnx_w.astype(F32) + lnx_b.astype(F32)
    out = (yn + (bonus_f + bonus_b).reshape(b, s, d)) * g.astype(F32)
    return out.astype(h.dtype) @ w_o


def mla_mixer(h, w_down, cq_gain, ckv_gain, w_uq, w_ukv, q_gain, k_gain, w_o, cos, sin):
    b, s, _ = h.shape
    nb = s // BLOCK
    down = h @ w_down
    cq = rms_norm(down[..., :MLA_Q_LORA], cq_gain)
    ckv = rms_norm(down[..., MLA_Q_LORA:MLA_Q_LORA + MLA_KV_LORA], ckv_gain)
    k_rope = down[..., MLA_Q_LORA + MLA_KV_LORA:]
    q = (cq @ w_uq).reshape(b, s, MLA_HEADS, MLA_NOPE + MLA_ROPE)
    kv = (ckv @ w_ukv).reshape(b, s, MLA_HEADS, MLA_NOPE + MLA_V)
    k = jnp.concatenate([kv[..., :MLA_NOPE], jnp.broadcast_to(k_rope[:, :, None, :], (b, s, MLA_HEADS, MLA_ROPE))], axis=-1)
    v = kv[..., MLA_NOPE:]
    q = rope_slice(rms_norm(q, q_gain), cos, sin, MLA_NOPE)
    k = rope_slice(rms_norm(k, k_gain), cos, sin, MLA_NOPE)
    scale = (MLA_NOPE + MLA_ROPE) ** -0.5
    qb = jnp.moveaxis(q.reshape(b, nb, BLOCK, MLA_HEADS, MLA_NOPE + MLA_ROPE), 1, 0)

    def attend(qblk):
        sc = jnp.einsum('bqhd,bkhd->bhqk', qblk, k).astype(F32) * scale
        p = jax.nn.softmax(sc, axis=-1)
        return jnp.einsum('bhqk,bkhd->bqhd', p.astype(v.dtype), v)

    o = lax.map(attend, qb)
    o = jnp.moveaxis(o, 0, 1).reshape(b, s, MLA_HEADS * MLA_V)
    return o @ w_o


def conv_ffn(h, w_up, conv_w, conv_b, w_down):
    s = h.shape[1]
    pad = CONV_WIDTH // 2
    u = h @ w_up
    up = jnp.pad(u, ((0, 0), (pad, pad), (0, 0)))
    acc = up[:, :s] * conv_w[0] + conv_b
    for t in range(1, CONV_WIDTH):
        acc = acc + up[:, t:t + s] * conv_w[t]
    gate, val = jnp.split(acc, 2, axis=-1)
    return (jax.nn.silu(gate) * val) @ w_down


def setup_inputs(seed: int = 0) -> dict:
    key = jax.random.key(seed)
    ks = iter(jax.random.split(key, 48))
    n_a = len(range(0, DEPTH, N_MIXERS))
    n_b = len(range(1, DEPTH, N_MIXERS))
    n_c = len(range(2, DEPTH, N_MIXERS))
    d = D_MODEL

    def nrm(shape, scale):
        return scale * jax.random.normal(next(ks), shape, F32)

    def unif(shape, lo, hi):
        return jax.random.uniform(next(ks), shape, F32, lo, hi)

    qkv_w = (SWA_HEADS + 2 * SWA_KV_HEADS) * SWA_HEAD_DIM
    return {
        'x': nrm((BATCH, SEQ, d), 1.0),
        'norm_tok': 1.0 + nrm((DEPTH, d), 0.05),
        'norm_ch': 1.0 + nrm((DEPTH, d), 0.05),
        'ffn_w_up': nrm((DEPTH, d, 2 * FFN_DIM), d ** -0.5),
        'ffn_conv_w': nrm((DEPTH, CONV_WIDTH, 2 * FFN_DIM), CONV_WIDTH ** -0.5),
        'ffn_conv_b': nrm((DEPTH, 2 * FFN_DIM), 0.02),
        'ffn_w_down': nrm((DEPTH, FFN_DIM, d), FFN_DIM ** -0.5),
        'swa_w_qkv': nrm((n_a, d, qkv_w), d ** -0.5),
        'swa_q_gain': 1.0 + nrm((n_a, SWA_HEAD_DIM), 0.05),
        'swa_k_gain': 1.0 + nrm((n_a, SWA_HEAD_DIM), 0.05),
        'swa_sinks': nrm((n_a, SWA_HEADS), 1.0),
        'swa_w_o': nrm((n_a, SWA_HEADS * SWA_HEAD_DIM, d), d ** -0.5),
        'rwkv_mu': unif((n_b, 6, d), 0.0, 1.0),
        'rwkv_w_r': nrm((n_b, d, d), d ** -0.5),
        'rwkv_w_k': nrm((n_b, d, d), d ** -0.5),
        'rwkv_w_v': nrm((n_b, d, d), d ** -0.5),
        'rwkv_w0': unif((n_b, 2, d), -6.0, -1.0),
        'rwkv_w1': nrm((n_b, 2, d, RWKV_DECAY_LORA), d ** -0.5),
        'rwkv_w2': nrm((n_b, 2, RWKV_DECAY_LORA, d), 0.5 * RWKV_DECAY_LORA ** -0.5),
        'rwkv_a0': nrm((n_b, 2, d), 0.5),
        'rwkv_a1': nrm((n_b, 2, d, RWKV_A_LORA), d ** -0.5),
        'rwkv_a2': nrm((n_b, 2, RWKV_A_LORA, d), 0.5 * RWKV_A_LORA ** -0.5),
        'rwkv_g1': nrm((n_b, d, RWKV_GATE_LORA), d ** -0.5),
        'rwkv_g2': nrm((n_b, RWKV_GATE_LORA, d), RWKV_GATE_LORA ** -0.5),
        'rwkv_k_k': 0.85 + nrm((n_b, d), 0.1),
        'rwkv_k_a': 1.0 + nrm((n_b, d), 0.1),
        'rwkv_r_k': nrm((n_b, RWKV_HEADS, RWKV_HEAD_DIM), 0.1),
        'rwkv_lnx_w': 1.0 + nrm((n_b, d), 0.05),
        'rwkv_lnx_b': nrm((n_b, d), 0.01),
        'rwkv_w_o': nrm((n_b, d, d), d ** -0.5),
        'mla_w_down': nrm((n_c, d, MLA_Q_LORA + MLA_KV_LORA + MLA_ROPE), d ** -0.5),
        'mla_cq_gain': 1.0 + nrm((n_c, MLA_Q_LORA), 0.05),
        'mla_ckv_gain': 1.0 + nrm((n_c, MLA_KV_LORA), 0.05),
        'mla_w_uq': nrm((n_c, MLA_Q_LORA, MLA_HEADS * (MLA_NOPE + MLA_ROPE)), MLA_Q_LORA ** -0.5),
        'mla_w_ukv': nrm((n_c, MLA_KV_LORA, MLA_HEADS * (MLA_NOPE + MLA_V)), MLA_KV_LORA ** -0.5),
        'mla_q_gain': 1.0 + nrm((n_c, MLA_NOPE + MLA_ROPE), 0.05),
        'mla_k_gain': 1.0 + nrm((n_c, MLA_NOPE + MLA_ROPE), 0.05),
        'mla_w_o': nrm((n_c, MLA_HEADS * MLA_V, d), d ** -0.5),
    }


def reference(x, norm_tok, norm_ch, ffn_w_up, ffn_conv_w, ffn_conv_b, ffn_w_down,
              swa_w_qkv, swa_q_gain, swa_k_gain, swa_sinks, swa_w_o,
              rwkv_mu, rwkv_w_r, rwkv_w_k, rwkv_w_v, rwkv_w0, rwkv_w1, rwkv_w2,
              rwkv_a0, rwkv_a1, rwkv_a2, rwkv_g1, rwkv_g2, rwkv_k_k, rwkv_k_a, rwkv_r_k,
              rwkv_lnx_w, rwkv_lnx_b, rwkv_w_o,
              mla_w_down, mla_cq_gain, mla_ckv_gain, mla_w_uq, mla_w_ukv,
              mla_q_gain, mla_k_gain, mla_w_o):
    s = x.shape[1]
    cos_a, sin_a = rope_tables(s, SWA_ROT)
    cos_c, sin_c = rope_tables(s, MLA_ROPE)
    for i in range(DEPTH):
        kind = i % N_MIXERS
        j = i // N_MIXERS
        h = rms_norm(x, norm_tok[i])
        if kind == 0:
            y = swa_mixer(h, swa_w_qkv[j], swa_q_gain[j], swa_k_gain[j], swa_sinks[j], swa_w_o[j], cos_a, sin_a)
        elif kind == 1:
            y = rwkv7_mixer(h, rwkv_mu[j], rwkv_w_r[j], rwkv_w_k[j], rwkv_w_v[j], rwkv_w0[j], rwkv_w1[j], rwkv_w2[j],
                            rwkv_a0[j], rwkv_a1[j], rwkv_a2[j], rwkv_g1[j], rwkv_g2[j], rwkv_k_k[j], rwkv_k_a[j],
                            rwkv_r_k[j], rwkv_lnx_w[j], rwkv_lnx_b[j], rwkv_w_o[j])
        else:
            y = mla_mixer(h, mla_w_down[j], mla_cq_gain[j], mla_ckv_gain[j], mla_w_uq[j], mla_w_ukv[j],
                          mla_q_gain[j], mla_k_gain[j], mla_w_o[j], cos_c, sin_c)
        x = x + y
        x = x + conv_ffn(rms_norm(x, norm_ch[i]), ffn_w_up[i], ffn_conv_w[i], ffn_conv_b[i], ffn_w_down[i])
    return x
```

```cpp
#include <hip/hip_runtime.h>
#include <cstdio>
#include <cstdint>

constexpr int DM = 1024, BATCH = 8, SEQ = 2048, DEPTH = 4;
constexpr int FFN = 2816, FF2 = 5632;
constexpr float NORM_EPS = 1e-6f;

__device__ __forceinline__ float wave_sum(float v) {
#pragma unroll
    for (int o = 32; o >= 1; o >>= 1) v += __shfl_xor(v, o);
    return v;
}
__device__ __forceinline__ float wave_max(float v) {
#pragma unroll
    for (int o = 32; o >= 1; o >>= 1) v = fmaxf(v, __shfl_xor(v, o));
    return v;
}

__global__ void rope_table_k(float* cosA, float* sinA, float* cosC, float* sinC) {
    int idx = blockIdx.x * blockDim.x + threadIdx.x;
    if (idx >= SEQ * 24) return;
    int s = idx / 24, j = idx % 24;
    if (j < 8) {
        float inv = (float)pow(500000.0, -(double)(2 * j) / 16.0);
        float ang = (float)s * inv;
        cosA[s * 8 + j] = (float)cos((double)ang); sinA[s * 8 + j] = (float)sin((double)ang);
    } else {
        int i = j - 8;
        float inv = (float)pow(500000.0, -(double)(2 * i) / 32.0);
        float ang = (float)s * inv;
        cosC[s * 16 + i] = (float)cos((double)ang); sinC[s * 16 + i] = (float)sin((double)ang);
    }
}

__global__ void rmsnorm_k(const float* in, int ld_in, const float* g, float* out, int ld_out, int rows, int dim) {
    int row = blockIdx.x * 4 + (threadIdx.x >> 6); int lane = threadIdx.x & 63;
    if (row >= rows) return;
    const float* p = in + (size_t)row * ld_in;
    float ss = 0.f;
    for (int c = lane; c < dim; c += 64) { float v = p[c]; ss += v * v; }
    ss = wave_sum(ss);
    float r = rsqrtf(ss / (float)dim + NORM_EPS);
    float* o = out + (size_t)row * ld_out;
    for (int c = lane; c < dim; c += 64) o[c] = p[c] * r * g[c];
}

__global__ void __launch_bounds__(256) gemm_k(const float* A, int lda, const float* W, int ldw, float* C, int ldc,
                                              int M, int N, int K, int accumulate, const float* mu, int S) {
    __shared__ float As[16][68];
    __shared__ float Ws[16][68];
    const int tid = threadIdx.x, tx = tid & 15, ty = tid >> 4;
    const int m0 = blockIdx.y * 64, n0 = blockIdx.x * 64;
    float acc[4][4];
#pragma unroll
    for (int i = 0; i < 4; ++i)
#pragma unroll
        for (int j = 0; j < 4; ++j) acc[i][j] = 0.f;
    for (int k0 = 0; k0 < K; k0 += 16) {
#pragma unroll
        for (int e = 0; e < 4; ++e) {
            int idx = tid + e * 256;
            int r = idx >> 4, kk = idx & 15;
            int m = m0 + r, k = k0 + kk;
            float a = 0.f;
            if (m < M && k < K) {
                a = A[(size_t)m * lda + k];
                if (mu) {
                    int s = m % S;
                    float hp = (s > 0) ? A[(size_t)(m - 1) * lda + k] : 0.f;
                    float hn = (s < S - 1) ? A[(size_t)(m + 1) * lda + k] : 0.f;
                    float xx = 0.5f * (hp + hn) - a;
                    a = a + xx * mu[k];
                }
            }
            As[kk][r] = a;
            int wk = idx >> 6, wn = idx & 63;
            int k2 = k0 + wk, n = n0 + wn;
            Ws[wk][wn] = (k2 < K && n < N) ? W[(size_t)k2 * ldw + n] : 0.f;
        }
        __syncthreads();
#pragma unroll
        for (int kk = 0; kk < 16; ++kk) {
            float a[4], b[4];
#pragma unroll
            for (int i = 0; i < 4; ++i) a[i] = As[kk][ty * 4 + i];
#pragma unroll
            for (int j = 0; j < 4; ++j) b[j] = Ws[kk][tx * 4 + j];
#pragma unroll
            for (int i = 0; i < 4; ++i)
#pragma unroll
                for (int j = 0; j < 4; ++j) acc[i][j] += a[i] * b[j];
        }
        __syncthreads();
    }
#pragma unroll
    for (int i = 0; i < 4; ++i) {
        int m = m0 + ty * 4 + i; if (m >= M) continue;
#pragma unroll
        for (int j = 0; j < 4; ++j) {
            int n = n0 + tx * 4 + j; if (n >= N) continue;
            float* c = C + (size_t)m * ldc + n;
            *c = accumulate ? (*c + acc[i][j]) : acc[i][j];
        }
    }
}

__global__ void unary_k(float* p, size_t n, int mode) {
    size_t i = (size_t)blockIdx.x * blockDim.x + threadIdx.x;
    if (i >= n) return;
    float v = p[i];
    p[i] = (mode == 0) ? tanhf(v) : 1.f / (1.f + expf(-v));
}

__global__ void swa_prep_k(float* qkv, const float* qg, const float* kg, const float* cosA, const float* sinA, int S) {
    int idx = blockIdx.x * blockDim.x + threadIdx.x;
    if (idx >= S * 20) return;
    int s = idx / 20, hh = idx % 20;
    float* p = qkv + (size_t)s * 1536 + hh * 64;
    const float* g = (hh < 16) ? qg : kg;
    float v[64]; float ss = 0.f;
#pragma unroll
    for (int d = 0; d < 64; ++d) { v[d] = p[d]; ss += v[d] * v[d]; }
    float r = rsqrtf(ss / 64.f + NORM_EPS);
#pragma unroll
    for (int d = 0; d < 64; ++d) v[d] = v[d] * r * g[d];
#pragma unroll
    for (int i = 0; i < 8; ++i) {
        float c = cosA[s * 8 + i], sn = sinA[s * 8 + i];
        float x1 = v[i], x2 = v[8 + i];
        v[i] = x1 * c - x2 * sn; v[8 + i] = x2 * c + x1 * sn;
    }
#pragma unroll
    for (int d = 0; d < 64; ++d) p[d] = v[d];
}

__global__ void __launch_bounds__(256) attn_k(const float* Q, int ldq, int dqk, const float* Kp, int ldk, int kstride, int koff,
                                              const float* Vp, int ldv, int vstride, int voff, int group, const float* sinks,
                                              int window, float scale, float* O, int ldo, int S, int H) {
    __shared__ float sc[4][2048];
    __shared__ float qs[4][96];
    const int w = threadIdx.x >> 6, lane = threadIdx.x & 63;
    const int pair = blockIdx.x * 4 + w;
    const int s = pair / H, h = pair % H;
    const int kvh = h / group;
    const float* q = Q + (size_t)s * ldq + h * dqk;
    for (int d = lane; d < dqk; d += 64) qs[w][d] = q[d];
    __syncthreads();
    int klo = 0, khi = S - 1;
    if (window >= 0) { klo = max(0, s - window); khi = min(S - 1, s + window); }
    const int nk = khi - klo + 1;
    float mx = -1e30f;
    for (int j = lane; j < nk; j += 64) {
        const float* kr = Kp + (size_t)(klo + j) * ldk + kvh * kstride + koff;
        float d = 0.f;
        for (int e = 0; e < dqk; ++e) d += qs[w][e] * kr[e];
        d *= scale; sc[w][j] = d; mx = fmaxf(mx, d);
    }
    mx = wave_max(mx);
    float sinkv = 0.f;
    if (sinks) { sinkv = sinks[h]; mx = fmaxf(mx, sinkv); }
    float sum = 0.f;
    for (int j = lane; j < nk; j += 64) { float p = expf(sc[w][j] - mx); sc[w][j] = p; sum += p; }
    sum = wave_sum(sum);
    if (sinks) sum += expf(sinkv - mx);
    __syncthreads();
    float o = 0.f;
    for (int j = 0; j < nk; ++j) o += sc[w][j] * Vp[(size_t)(klo + j) * ldv + kvh * vstride + voff + lane];
    O[(size_t)s * ldo + h * 64 + lane] = o / sum;
}

__global__ void rwkv_post1_k(const float* k, const float* wl  , const float* al  , const float* w0  , const float* a0,
                             const float* k_k, const float* k_a, float* an, float* decay  , float* kd, float* bb, int S) {
    int idx = blockIdx.x * 4 + (threadIdx.x >> 6); int lane = threadIdx.x & 63;
    if (idx >= S * 16) return;
    int s = idx / 16, h = idx % 16; int c = h * 64 + lane;
    float kv = k[(size_t)s * 1024 + c];
    float kkv = kv * k_k[c];
    float nn = wave_sum(kkv * kkv);
    kkv = kkv / fmaxf(sqrtf(nn), 1e-12f);
    an[(size_t)s * 1024 + c] = -kkv;
    for (int d = 0; d < 2; ++d) {
        float wv = w0[d * 1024 + c] + wl[(size_t)s * 2048 + d * 1024 + c];
        float x = -wv;
        float sp = fmaxf(x, 0.f) + log1pf(expf(-fabsf(x)));
        float dec = expf(-expf(-sp - 0.5f));
        float av = a0[d * 1024 + c] + al[(size_t)s * 2048 + d * 1024 + c];
        av = 1.f / (1.f + expf(-av));
        size_t o = ((size_t)d * S + s) * 1024 + c;
        decay[o] = dec; kd[o] = kv * (1.f + (av - 1.f) * k_a[c]); bb[o] = kkv * av;
    }
}

__global__ void __launch_bounds__(64) rwkv_scan_k(const float* r, const float* vv, const float* an, const float* decay, const float* kd, const float* bb, float* y  , int S) {
    const int h = blockIdx.x & 15, dir = blockIdx.x >> 4, lane = threadIdx.x;
    float st[64];
#pragma unroll
    for (int k = 0; k < 64; ++k) st[k] = 0.f;
    const float* dW = decay + (size_t)dir * S * 1024; const float* dK = kd + (size_t)dir * S * 1024; const float* dB = bb + (size_t)dir * S * 1024;
    float* yo = y + (size_t)dir * S * 1024;
    for (int i = 0; i < S; ++i) {
        const int t = dir ? (S - 1 - i) : i;
        const size_t base = (size_t)t * 1024 + h * 64;
        const float* ap = an + base; const float* wp = dW + base; const float* kp = dK + base; const float* bp = dB + base; const float* rp = r + base;
        const float vt = vv[base + lane];
        float sa = 0.f;
#pragma unroll
        for (int k = 0; k < 64; ++k) sa += st[k] * ap[k];
        float yy = 0.f;
#pragma unroll
        for (int k = 0; k < 64; ++k) { st[k] = st[k] * wp[k] + sa * bp[k] + vt * kp[k]; yy += st[k] * rp[k]; }
        yo[base + lane] = yy;
    }
}

__global__ void rwkv_post2_k(const float* y, const float* r, const float* kd, const float* vv, const float* g, const float* r_k, const float* lnw, const float* lnb, float* out, int S) {
    int idx = blockIdx.x * 4 + (threadIdx.x >> 6); int lane = threadIdx.x & 63;
    if (idx >= S * 16) return;
    int s = idx / 16, h = idx % 16; int c = h * 64 + lane; size_t o = (size_t)s * 1024 + c;
    float yv = y[o] + y[(size_t)S * 1024 + o];
    float mean = wave_sum(yv) / 64.f;
    float dv = yv - mean;
    float var = wave_sum(dv * dv) / 64.f;
    float yn = dv * rsqrtf(var + 64e-5f) * lnw[c] + lnb[c];
    float rv = r[o], rk = r_k[c];
    float bf = wave_sum(rv * kd[o] * rk);
    float bbk = wave_sum(rv * kd[(size_t)S * 1024 + o] * rk);
    float v = vv[o];
    out[o] = (yn + (bf + bbk) * v) * g[o];
}

__global__ void mla_prep_k(float* q, const float* kv, const float* down  , const float* qg, const float* kg, const float* cosC, const float* sinC, float* Kb, int S) {
    int idx = blockIdx.x * 4 + (threadIdx.x >> 6); int lane = threadIdx.x & 63;
    if (idx >= S * 32) return;
    int s = idx / 32, hh = idx % 32; int h = hh & 15; bool isk = hh >= 16;
    float lo, hi = 0.f;
    if (!isk) { const float* p = q + (size_t)s * 1536 + h * 96; lo = p[lane]; if (lane < 32) hi = p[64 + lane]; }
    else { const float* p = kv + (size_t)s * 2048 + h * 128; lo = p[lane]; if (lane < 32) hi = down[(size_t)s * 672 + 640 + lane]; }
    const float* g = isk ? kg : qg;
    float ss = wave_sum(lo * lo + hi * hi);
    float r = rsqrtf(ss / 96.f + NORM_EPS);
    lo = lo * r * g[lane];
    if (lane < 32) hi = hi * r * g[64 + lane];
    float other = __shfl_xor(hi, 16);
    float c = cosC[s * 16 + (lane & 15)], sn = sinC[s * 16 + (lane & 15)];
    float hin = hi;
    if (lane < 16) hin = hi * c - other * sn;
    else if (lane < 32) hin = hi * c + other * sn;
    float* o = isk ? (Kb + ((size_t)s * 16 + h) * 96) : (q + (size_t)s * 1536 + h * 96);
    o[lane] = lo;
    if (lane < 32) o[64 + lane] = hin;
}

__global__ void ffn_conv_k(const float* u  , const float* cw  , const float* cb, float* act  , int S) {
    size_t idx = (size_t)blockIdx.x * blockDim.x + threadIdx.x;
    if (idx >= (size_t)S * FFN) return;
    int s = (int)(idx / FFN), f = (int)(idx % FFN);
    float gv[2];
#pragma unroll
    for (int half = 0; half < 2; ++half) {
        int c = f + half * FFN;
        float a = cb[c] + u[(size_t)s * FF2 + c] * cw[FF2 + c];
        if (s > 0) a += u[(size_t)(s - 1) * FF2 + c] * cw[c];
        if (s < S - 1) a += u[(size_t)(s + 1) * FF2 + c] * cw[2 * FF2 + c];
        gv[half] = a;
    }
    float gate = gv[0];
    act[idx] = gate / (1.f + expf(-gate)) * gv[1];
}

static void gemm(hipStream_t st, const float* A, int lda, const float* W, int ldw, float* C, int ldc, int M, int N, int K, int acc, const float* mu = nullptr) {
    dim3 grid((N + 63) / 64, (M + 63) / 64);
    hipLaunchKernelGGL(gemm_k, grid, dim3(256), 0, st, A, lda, W, ldw, C, ldc, M, N, K, acc, mu, SEQ);
}

extern "C" void kernel_launch(void* const* d_in, const int* in_sizes, int n_in, void* d_out, int out_size, void* d_ws, size_t ws_size, hipStream_t stream) {
    if (n_in != 38 || out_size != BATCH * SEQ * DM) { fprintf(stderr, "kernel_launch: unexpected shapes\n"); return; }
    const float* in[38]; for (int i = 0; i < 38; ++i) in[i] = (const float*)d_in[i];
    float* out = (float*)d_out;
    const int S = SEQ;
    float* ws = (float*)d_ws; size_t off = 0;
    auto take = [&](size_t n) { float* p = ws + off; off += (n + 63) & ~(size_t)63; return p; };
    float* cosA = take(S * 8); float* sinA = take(S * 8); float* cosC = take(S * 16); float* sinC = take(S * 16);
    float* H = take((size_t)S * DM);
    float* BIG = take((size_t)S * FF2);
    float* T1 = take((size_t)S * FFN);
    float* T2 = take((size_t)S * 16 * 96);
    float* T3 = take((size_t)S * 1024);
    float* Rr = take((size_t)S * 1024); float* Rk = take((size_t)S * 1024); float* Rv = take((size_t)S * 1024); float* Rg = take((size_t)S * 1024);
    float* Rw1 = take((size_t)S * 128); float* Ra1 = take((size_t)S * 128); float* Rg1 = take((size_t)S * 160);
    float* Rwl = take((size_t)S * 2048); float* Ral = take((size_t)S * 2048);
    float* Ran = take((size_t)S * 1024); float* Rdec = take((size_t)2 * S * 1024); float* Rkd = take((size_t)2 * S * 1024); float* Rbb = take((size_t)2 * S * 1024);
    float* Ry = take((size_t)2 * S * 1024);
    if (off * 4 > ws_size) { fprintf(stderr, "kernel_launch: workspace too small\n"); return; }

    hipLaunchKernelGGL(rope_table_k, dim3((S * 24 + 255) / 256), dim3(256), 0, stream, cosA, sinA, cosC, sinC);
    (void)hipMemcpyAsync(out, in[0], (size_t)BATCH * S * DM * 4, hipMemcpyDeviceToDevice, stream);

    for (int b = 0; b < BATCH; ++b) {
        float* x = out + (size_t)b * S * DM;
        for (int i = 0; i < DEPTH; ++i) {
            const int kind = i % 3, j = i / 3;
            hipLaunchKernelGGL(rmsnorm_k, dim3(S / 4), dim3(256), 0, stream, x, DM, in[1] + i * DM, H, DM, S, DM);
            if (kind == 0) {
                const float* wqkv = in[7] + (size_t)j * 1024 * 1536;
                gemm(stream, H, DM, wqkv, 1536, BIG, 1536, S, 1536, 1024, 0);
                hipLaunchKernelGGL(swa_prep_k, dim3((S * 20 + 255) / 256), dim3(256), 0, stream, BIG, in[8] + j * 64, in[9] + j * 64, cosA, sinA, S);
                hipLaunchKernelGGL(attn_k, dim3(S * 16 / 4), dim3(256), 0, stream, BIG, 1536, 64, BIG, 1536, 64, 1024, BIG, 1536, 64, 1280, 4, in[10] + j * 16, 128, 0.125f, T1, 1024, S, 16);
                gemm(stream, T1, 1024, in[11] + (size_t)j * 1024 * 1024, 1024, x, DM, S, 1024, 1024, 1);
            } else if (kind == 1) {
                const float* mu = in[12] + (size_t)j * 6 * 1024;
                gemm(stream, H, DM, in[13] + (size_t)j * 1024 * 1024, 1024, Rr, 1024, S, 1024, 1024, 0, mu + 0 * 1024);
                gemm(stream, H, DM, in[14] + (size_t)j * 1024 * 1024, 1024, Rk, 1024, S, 1024, 1024, 0, mu + 2 * 1024);
                gemm(stream, H, DM, in[15] + (size_t)j * 1024 * 1024, 1024, Rv, 1024, S, 1024, 1024, 0, mu + 3 * 1024);
                gemm(stream, H, DM, in[22] + (size_t)j * 1024 * 160, 160, Rg1, 160, S, 160, 1024, 0, mu + 5 * 1024);
                hipLaunchKernelGGL(unary_k, dim3(((size_t)S * 160 + 255) / 256), dim3(256), 0, stream, Rg1, (size_t)S * 160, 1);
                gemm(stream, Rg1, 160, in[23] + (size_t)j * 160 * 1024, 1024, Rg, 1024, S, 1024, 160, 0);
                for (int d = 0; d < 2; ++d) {
                    gemm(stream, H, DM, in[17] + ((size_t)j * 2 + d) * 1024 * 64, 64, Rw1 + d * 64, 128, S, 64, 1024, 0, mu + 1 * 1024);
                    gemm(stream, H, DM, in[20] + ((size_t)j * 2 + d) * 1024 * 64, 64, Ra1 + d * 64, 128, S, 64, 1024, 0, mu + 4 * 1024);
                }
                hipLaunchKernelGGL(unary_k, dim3(((size_t)S * 128 + 255) / 256), dim3(256), 0, stream, Rw1, (size_t)S * 128, 0);
                for (int d = 0; d < 2; ++d) {
                    gemm(stream, Rw1 + d * 64, 128, in[18] + ((size_t)j * 2 + d) * 64 * 1024, 1024, Rwl + d * 1024, 2048, S, 1024, 64, 0);
                    gemm(stream, Ra1 + d * 64, 128, in[21] + ((size_t)j * 2 + d) * 64 * 1024, 1024, Ral + d * 1024, 2048, S, 1024, 64, 0);
                }
                hipLaunchKernelGGL(rwkv_post1_k, dim3(S * 16 / 4), dim3(256), 0, stream, Rk, Rwl, Ral, in[16] + (size_t)j * 2048, in[19] + (size_t)j * 2048,
                                   in[24] + j * 1024, in[25] + j * 1024, Ran, Rdec, Rkd, Rbb, S);
                hipLaunchKernelGGL(rwkv_scan_k, dim3(32), dim3(64), 0, stream, Rr, Rv, Ran, Rdec, Rkd, Rbb, Ry, S);
                hipLaunchKernelGGL(rwkv_post2_k, dim3(S * 16 / 4), dim3(256), 0, stream, Ry, Rr, Rkd, Rv, Rg, in[26] + j * 1024, in[27] + j * 1024, in[28] + j * 1024, T3, S);
                gemm(stream, T3, 1024, in[29] + (size_t)j * 1024 * 1024, 1024, x, DM, S, 1024, 1024, 1);
            } else {
                float* down = T3;
                gemm(stream, H, DM, in[30] + (size_t)j * 1024 * 672, 672, down, 672, S, 672, 1024, 0);
                float* cq = Rr; float* ckv = Rk;
                hipLaunchKernelGGL(rmsnorm_k, dim3(S / 4), dim3(256), 0, stream, down, 672, in[31] + j * 384, cq, 384, S, 384);
                hipLaunchKernelGGL(rmsnorm_k, dim3(S / 4), dim3(256), 0, stream, down + 384, 672, in[32] + j * 256, ckv, 256, S, 256);
                float* q = T1;
                gemm(stream, cq, 384, in[33] + (size_t)j * 384 * 1536, 1536, q, 1536, S, 1536, 384, 0);
                gemm(stream, ckv, 256, in[34] + (size_t)j * 256 * 2048, 2048, BIG, 2048, S, 2048, 256, 0);
                hipLaunchKernelGGL(mla_prep_k, dim3(S * 32 / 4), dim3(256), 0, stream, q, BIG, down, in[35] + j * 96, in[36] + j * 96, cosC, sinC, T2, S);
                float* ao = Rv;
                hipLaunchKernelGGL(attn_k, dim3(S * 16 / 4), dim3(256), 0, stream, q, 1536, 96, T2, 16 * 96, 96, 0, BIG, 2048, 128, 64, 1, (const float*)nullptr, -1, 0.10206207261596577f, ao, 1024, S, 16);
                gemm(stream, ao, 1024, in[37] + (size_t)j * 1024 * 1024, 1024, x, DM, S, 1024, 1024, 1);
            }
            hipLaunchKernelGGL(rmsnorm_k, dim3(S / 4), dim3(256), 0, stream, x, DM, in[2] + i * DM, H, DM, S, DM);
            gemm(stream, H, DM, in[3] + (size_t)i * 1024 * FF2, FF2, BIG, FF2, S, FF2, 1024, 0);
            hipLaunchKernelGGL(ffn_conv_k, dim3(((size_t)S * FFN + 255) / 256), dim3(256), 0, stream, BIG, in[4] + (size_t)i * 3 * FF2, in[5] + (size_t)i * FF2, T1, S);
            gemm(stream, T1, FFN, in[6] + (size_t)i * FFN * 1024, 1024, x, DM, S, 1024, FFN, 1);
        }
    }
}
```

```cpp
#include <hip/hip_runtime.h>
#include <hip/hip_cooperative_groups.h>
#include <cstdio>
#include <cstdint>
namespace cg = cooperative_groups;

constexpr int DM = 1024, BATCH = 8, SEQ = 2048, DEPTH = 4;
constexpr int FFN = 2816, FF2 = 5632;
constexpr float NORM_EPS = 1e-6f;

__device__ __forceinline__ int opaque_tid() { int t = threadIdx.x; asm volatile("" : "+v"(t)); return t; }
__device__ __forceinline__ int opaque_s(int v) { asm volatile("" : "+s"(v)); return v; }
__device__ __forceinline__ float wave_sum(float v) {
#pragma unroll
    for (int o = 32; o >= 1; o >>= 1) v += __shfl_xor(v, o);
    return v;
}
namespace pg8 {
#define PG8_LAS __attribute__((address_space(3)))
typedef unsigned short bf16_t;
typedef short bf16x8 __attribute__((ext_vector_type(8)));
typedef float f32x4 __attribute__((ext_vector_type(4)));
typedef unsigned u32x4 __attribute__((ext_vector_type(4)));
constexpr int BM = 256, BK = 64, HALF = 128, HTB = HALF * BK * 2  , STAGE_BYTES = 8 * HTB, NXCD = 8, WGM = 8;

__host__ __device__ __forceinline__ int lds_byte(int r, int c) { const int st = (r >> 4) * 2 + (c >> 5), rr = r & 15, cc = c & 31, ob = rr * 64 + cc * 2; return st * 1024 + (ob ^ (((ob >> 9) & 1) << 5)); }
__host__ __device__ __forceinline__ void stage_rc(int b, int& R, int& C) { const int st = b / 1024, sb = b % 1024, swz = sb ^ (((sb >> 9) & 1) << 5); R = (st >> 1) * 16 + swz / 64; C = (st & 1) * 32 + (swz % 64) / 2; }
__host__ __device__ __forceinline__ int perm32(int rho) { const int n = rho >> 4, i = rho & 15; return 8 * (i >> 2) + 4 * n + (i & 3); }

struct Unit { int pm, pn; };
struct Gemm { const bf16_t* A; const bf16_t* Bt; int M, N, K, lda, ldb; };

struct StaticOrder {
    int nM, nN, nwg, G, c;
    __host__ __device__ void init(int M, int N, int G_, int c_) { nM = M / BM; nN = N / BM; nwg = nM * nN; G = G_; c = c_; }
    __host__ __device__ bool next(int i, Unit& u) const {
        const long L = (long)i * G + c; if (L >= nwg) return false;
        int wgid = (int)L; { const int q = nwg / NXCD, r = nwg % NXCD, xcd = wgid % NXCD, off = wgid / NXCD; wgid = (xcd < r ? xcd * (q + 1) : r * (q + 1) + (xcd - r) * q) + off; }
        const int nig = WGM * nN, gid = wgid / nig, fm = gid * WGM, gsz = (nM - fm) < WGM ? (nM - fm) : WGM;
        u.pm = fm + ((wgid % nig) % gsz); u.pn = (wgid % nig) / gsz; return true;
    }
    __device__ __forceinline__ void a_ready(const Unit&) const {}
    __device__ __forceinline__ void done(const Unit&) const {}
};

template <class Epi, class Sched, bool ALIGN_EPI = false, bool SP2 = false>
__device__ __forceinline__ void gemm_phase(PG8_LAS unsigned char* lds, const Gemm g, const Sched& S, const Epi& E) {
    const int tid = opaque_tid(), wid = __builtin_amdgcn_readfirstlane(tid >> 6), lane = tid & 63, wr = wid >> 2, wc = wid & 3, fr = lane & 15, fq = lane >> 4;
    const int K = g.K, nt = K / BK;
    unsigned voffA[2], voffB[2];
#pragma unroll
    for (int i = 0; i < 2; ++i) { int R, C; stage_rc(tid * 16 + i * 8192, R, C); const int Rb = Epi::PERM ? ((R & ~31) + perm32(R & 31)) : R;
        voffA[i] = (unsigned)(R * g.lda + C) * 2u; voffB[i] = (unsigned)(Rb * g.ldb + C) * 2u; }
    const size_t kstep = (size_t)(BK * 2);
    const size_t hstepA = (size_t)HALF * g.lda * 2, hstepB = (size_t)HALF * g.ldb * 2;
    const size_t tstepA = 2 * hstepA, tstepB = 2 * hstepB;
    const unsigned ldsw = (unsigned)wid * 1024u;
    const int aoff = lds_byte(wr * 64 + fr, fq * 8), boff = lds_byte(wc * 32 + fr, fq * 8);
#define PG8_SA(b, h) (((b) * 2 + (h)) * HTB)
#define PG8_SB(b, h) ((4 + (b) * 2 + (h)) * HTB)
#define PG8_STAGE(bufoff, gbase, voff) do { _Pragma("unroll") for (int _i = 0; _i < 2; ++_i) \
        __builtin_amdgcn_global_load_lds((const unsigned*)((const char*)(gbase) + (voff)[_i]), (PG8_LAS unsigned*)(lds + (bufoff) + ldsw + _i * 8192), 16, 0, 0); } while (0)
#define PG8_LDA(dst, b, h) do { _Pragma("unroll") for (int m = 0; m < 4; ++m) _Pragma("unroll") for (int k = 0; k < 2; ++k) dst[m][k] = *(const PG8_LAS bf16x8*)(lds + PG8_SA(b, h) + aoff + m * 2048 + k * 1024); } while (0)
#define PG8_LDB(dst, b, h) do { _Pragma("unroll") for (int n = 0; n < 2; ++n) _Pragma("unroll") for (int k = 0; k < 2; ++k) dst[n][k] = *(const PG8_LAS bf16x8*)(lds + PG8_SB(b, h) + boff + n * 2048 + k * 1024); } while (0)
#define PG8_MMA(ai, bj, At, Bt) do { __builtin_amdgcn_s_setprio(1); _Pragma("unroll") for (int m = 0; m < 4; ++m) _Pragma("unroll") for (int n = 0; n < 2; ++n) _Pragma("unroll") for (int k = 0; k < 2; ++k) \
        acc[ai][bj][m][n] = __builtin_amdgcn_mfma_f32_16x16x32_bf16(Bt[n][k], At[m][k], acc[ai][bj][m][n], 0, 0, 0); __builtin_amdgcn_s_setprio(0); } while (0)
#define PG8_WAIT_V(n) asm volatile("s_waitcnt vmcnt(" #n ")" ::: "memory")
#define PG8_WAIT_L(n) asm volatile("s_waitcnt lgkmcnt(" #n ")" ::: "memory")
#define PG8_BAR __builtin_amdgcn_s_barrier()
#define PG8_SCHED __builtin_amdgcn_sched_barrier(0)
    Unit cur, nxt; int ui = 0;
    if (!S.next(0, cur)) return;
    f32x4 acc[2][2][4][2];
#pragma unroll
    for (int a = 0; a < 2; ++a)
#pragma unroll
        for (int b = 0; b < 2; ++b)
#pragma unroll
            for (int m = 0; m < 4; ++m)
#pragma unroll
                for (int n = 0; n < 2; ++n) acc[a][b][m][n] = (f32x4){0.f, 0.f, 0.f, 0.f};
    bf16x8 At[4][2], B0[2][2], B1[2][2];
    const char* cA = (const char*)g.A + (size_t)cur.pm * tstepA; const char* cB = (const char*)g.Bt + (size_t)cur.pn * tstepB;
    S.a_ready(cur);
    if constexpr (SP2) {
        PG8_STAGE(PG8_SB(0, 0), cB, voffB); PG8_STAGE(PG8_SB(0, 1), cB + hstepB, voffB); PG8_STAGE(PG8_SA(0, 0), cA, voffA); PG8_STAGE(PG8_SA(0, 1), cA + hstepA, voffA);
        if (wr == 1) PG8_BAR;
        PG8_WAIT_V(2); PG8_BAR;
        PG8_STAGE(PG8_SB(1, 0), cB + kstep, voffB); PG8_STAGE(PG8_SA(1, 0), cA + kstep, voffA); PG8_STAGE(PG8_SB(1, 1), cB + hstepB + kstep, voffB);
        PG8_WAIT_V(6); PG8_BAR;
    } else {
        PG8_STAGE(PG8_SB(0, 0), cB, voffB); PG8_STAGE(PG8_SA(0, 0), cA, voffA); PG8_STAGE(PG8_SB(0, 1), cB + hstepB, voffB); PG8_STAGE(PG8_SA(0, 1), cA + hstepA, voffA);
        if (wr == 1) PG8_BAR;
        PG8_WAIT_V(4); PG8_BAR;
        PG8_STAGE(PG8_SB(1, 0), cB + kstep, voffB); PG8_STAGE(PG8_SA(1, 0), cA + kstep, voffA); PG8_STAGE(PG8_SB(1, 1), cB + hstepB + kstep, voffB);
        PG8_WAIT_V(6); PG8_BAR;
    }
    for (;;) {
        const bool has_next = S.next(ui + 1, nxt);
        const char* nA = has_next ? (const char*)g.A + (size_t)nxt.pm * tstepA : cA; const char* nB = has_next ? (const char*)g.Bt + (size_t)nxt.pn * tstepB : cB;
        for (int t = 0; t < nt; t += 2) {
            const bool last = (t == nt - 2);
            const char* a1 = cA + (size_t)(t + 1) * kstep;
            const char* a2 = last ? nA : cA + (size_t)(t + 2) * kstep; const char* b2 = last ? nB : cB + (size_t)(t + 2) * kstep;
            const char* a3 = a2 + kstep; const char* b3 = b2 + kstep;
            if (last && has_next) S.a_ready(nxt);
            if constexpr (SP2) {
            PG8_LDB(B0, 0, 0); PG8_LDB(B1, 0, 1); PG8_SCHED; PG8_LDA(At, 0, 0); PG8_STAGE(PG8_SA(1, 1), a1 + hstepA, voffA);
            PG8_WAIT_V(8); PG8_WAIT_L(0); PG8_BAR; PG8_MMA(0, 0, At, B0); PG8_MMA(0, 1, At, B1); PG8_BAR; PG8_SCHED;
            PG8_LDA(At, 0, 1); PG8_STAGE(PG8_SB(0, 0), b2, voffB); PG8_STAGE(PG8_SB(0, 1), b2 + hstepB, voffB); PG8_STAGE(PG8_SA(0, 0), a2, voffA);
            PG8_WAIT_V(8); PG8_WAIT_L(0); PG8_BAR; PG8_MMA(1, 0, At, B0); PG8_MMA(1, 1, At, B1); PG8_BAR; PG8_SCHED;
            PG8_LDB(B0, 1, 0); PG8_LDB(B1, 1, 1); PG8_SCHED; PG8_LDA(At, 1, 0); PG8_STAGE(PG8_SA(0, 1), a2 + hstepA, voffA);
            PG8_WAIT_V(8); PG8_WAIT_L(0); PG8_BAR; PG8_MMA(0, 0, At, B0); PG8_MMA(0, 1, At, B1); PG8_BAR; PG8_SCHED;
            PG8_LDA(At, 1, 1); PG8_STAGE(PG8_SB(1, 0), b3, voffB); PG8_STAGE(PG8_SB(1, 1), b3 + hstepB, voffB); PG8_STAGE(PG8_SA(1, 0), a3, voffA);
            PG8_WAIT_V(8); PG8_WAIT_L(0); PG8_BAR; PG8_MMA(1, 0, At, B0); PG8_MMA(1, 1, At, B1); PG8_BAR; PG8_SCHED;
            } else {
            PG8_LDB(B0, 0, 0); PG8_SCHED; PG8_LDA(At, 0, 0); PG8_STAGE(PG8_SA(1, 1), a1 + hstepA, voffA);
            PG8_WAIT_L(8); PG8_BAR; PG8_WAIT_L(0); PG8_MMA(0, 0, At, B0); PG8_BAR; PG8_SCHED;
            PG8_LDB(B1, 0, 1); PG8_STAGE(PG8_SB(0, 0), b2, voffB);
            PG8_BAR; PG8_WAIT_L(0); PG8_MMA(0, 1, At, B1); PG8_BAR;
            PG8_LDA(At, 0, 1); PG8_STAGE(PG8_SA(0, 0), a2, voffA);
            PG8_BAR; PG8_WAIT_L(0); PG8_MMA(1, 0, At, B0); PG8_BAR; PG8_SCHED;
            PG8_STAGE(PG8_SB(0, 1), b2 + hstepB, voffB);
            PG8_WAIT_V(6); PG8_BAR; PG8_MMA(1, 1, At, B1); PG8_BAR;
            PG8_LDB(B0, 1, 0); PG8_SCHED; PG8_LDA(At, 1, 0); PG8_STAGE(PG8_SA(0, 1), a2 + hstepA, voffA);
            PG8_WAIT_L(8); PG8_BAR; PG8_WAIT_L(0); PG8_MMA(0, 0, At, B0); PG8_BAR; PG8_SCHED;
            PG8_LDB(B1, 1, 1); PG8_STAGE(PG8_SB(1, 0), b3, voffB);
            PG8_BAR; PG8_WAIT_L(0); PG8_MMA(0, 1, At, B1); PG8_BAR;
            PG8_LDA(At, 1, 1); PG8_STAGE(PG8_SA(1, 0), a3, voffA);
            PG8_BAR; PG8_WAIT_L(0); PG8_MMA(1, 0, At, B0); PG8_BAR; PG8_SCHED;
            PG8_STAGE(PG8_SB(1, 1), b3 + hstepB, voffB);
            PG8_WAIT_V(6); PG8_BAR; PG8_MMA(1, 1, At, B1); PG8_BAR;
            }
        }
        if constexpr (ALIGN_EPI) { if (wr == 0) PG8_BAR; }
        if constexpr (!Epi::AFTER_DRAIN) { E(acc, cur, wr, wc, fr, fq); S.done(cur); }
        if (!has_next) break;
#pragma unroll
        for (int a = 0; a < 2; ++a)
#pragma unroll
            for (int b = 0; b < 2; ++b)
#pragma unroll
                for (int m = 0; m < 4; ++m)
#pragma unroll
                    for (int n = 0; n < 2; ++n) acc[a][b][m][n] = (f32x4){0.f, 0.f, 0.f, 0.f};
        cur = nxt; cA = nA; cB = nB; ++ui;
        if constexpr (ALIGN_EPI) { if (wr == 1) PG8_BAR; }
    }
    PG8_WAIT_V(0);
    if constexpr (!ALIGN_EPI) { if (wr == 0) PG8_BAR; }
    PG8_BAR;
    if constexpr (Epi::AFTER_DRAIN) { E.fused(acc, cur, wr, wc, fr, fq, lds, wid, lane); S.done(cur); }
#undef PG8_SA
#undef PG8_SB
#undef PG8_STAGE
#undef PG8_LDA
#undef PG8_LDB
#undef PG8_MMA
#undef PG8_WAIT_V
#undef PG8_WAIT_L
#undef PG8_BAR
#undef PG8_SCHED
}
}

using pg8::bf16_t; using pg8::f32x4; using pg8::u32x4; using pg8::Unit;
#define LAS __attribute__((address_space(3)))
constexpr int MTOK = BATCH * SEQ;
constexpr int LDS_BYTES = 147456;

__device__ __forceinline__ unsigned f2bf(float f) { unsigned u = __builtin_bit_cast(unsigned, f); return (u + 0x7fffu + ((u >> 16) & 1u)) >> 16; }
typedef float f32x2_t __attribute__((ext_vector_type(2))); typedef __bf16 bf16x2_t __attribute__((ext_vector_type(2)));
__device__ __forceinline__ unsigned pk2(float lo, float hi) { f32x2_t v = {lo, hi}; bf16x2_t b = __builtin_convertvector(v, bf16x2_t); return __builtin_bit_cast(unsigned, b); }
__device__ __forceinline__ float bf2f(unsigned short b) { return __builtin_bit_cast(float, (unsigned)b << 16); }
__device__ __forceinline__ unsigned pkh2(float lo, float hi) { return (unsigned)__builtin_bit_cast(unsigned short, (_Float16)lo) | ((unsigned)__builtin_bit_cast(unsigned short, (_Float16)hi) << 16); }

struct RowScale { const float* ssp; int stride, off, cnt; float inv_dim; };
__device__ __forceinline__ float row_rstd(const RowScale& rs, int row) {
    if (!rs.ssp) return 1.f;
    const float* p = rs.ssp + (size_t)row * rs.stride + rs.off; float s = 0.f;
    for (int i = 0; i < rs.cnt; i += 4) { const f32x4 v = *(const f32x4*)(p + i); s += (v[0] + v[1]) + (v[2] + v[3]); }
    return rsqrtf(s * rs.inv_dim + NORM_EPS);
}
struct EpiScaleBf16 {
    static constexpr bool PERM = true, AFTER_DRAIN = false;
    bf16_t* O; int ldc; RowScale rs; float* ssp2; int ssp2_stride;
    __device__ __forceinline__ void operator()(const f32x4 (&acc)[2][2][4][2], const Unit& u, int wr, int wc, int fr, int fq) const {
#pragma unroll
        for (int ai = 0; ai < 2; ++ai)
#pragma unroll
            for (int m = 0; m < 4; ++m) {
                const int row = u.pm * 256 + ai * 128 + wr * 64 + m * 16 + fr; const float sc = row_rstd(rs, row);
#pragma unroll
                for (int bj = 0; bj < 2; ++bj) {
                    const f32x4 v0 = acc[ai][bj][m][0] * sc, v1 = acc[ai][bj][m][1] * sc;
                    u32x4 w; w.x = pk2(v0[0], v0[1]); w.y = pk2(v0[2], v0[3]); w.z = pk2(v1[0], v1[1]); w.w = pk2(v1[2], v1[3]);
                    *(u32x4*)(O + (size_t)row * ldc + u.pn * 256 + bj * 128 + wc * 32 + 8 * fq) = w;
                    if (ssp2) { float ss = (v0[0] * v0[0] + v0[1] * v0[1]) + (v0[2] * v0[2] + v0[3] * v0[3]) + (v1[0] * v1[0] + v1[1] * v1[1]) + (v1[2] * v1[2] + v1[3] * v1[3]);
                        ss += __shfl_xor(ss, 16); ss += __shfl_xor(ss, 32);
                        if (fq == 0) ssp2[(size_t)row * ssp2_stride + u.pn * 8 + bj * 4 + wc] = ss; }
                }
            }
    }
};
struct EpiResid {
    static constexpr bool PERM = true, AFTER_DRAIN = false;
    const float* base; float* out; bf16_t* xb; float* ssp;
    __device__ __forceinline__ void operator()(const f32x4 (&acc)[2][2][4][2], const Unit& u, int wr, int wc, int fr, int fq) const {
#pragma unroll
        for (int ai = 0; ai < 2; ++ai)
#pragma unroll
            for (int m = 0; m < 4; ++m) {
                const int row = u.pm * 256 + ai * 128 + wr * 64 + m * 16 + fr; float ss = 0.f;
#pragma unroll
                for (int bj = 0; bj < 2; ++bj) {
                    const size_t o = (size_t)row * DM + u.pn * 256 + bj * 128 + wc * 32 + 8 * fq;
                    const f32x4 v0 = *(const f32x4*)(base + o) + acc[ai][bj][m][0], v1 = *(const f32x4*)(base + o + 4) + acc[ai][bj][m][1];
                    *(f32x4*)(out + o) = v0; *(f32x4*)(out + o + 4) = v1;
                    u32x4 w; w.x = pk2(v0[0], v0[1]); w.y = pk2(v0[2], v0[3]); w.z = pk2(v1[0], v1[1]); w.w = pk2(v1[2], v1[3]);
                    *(u32x4*)(xb + o) = w;
                    ss += (v0[0] * v0[0] + v0[1] * v0[1]) + (v0[2] * v0[2] + v0[3] * v0[3]) + (v1[0] * v1[0] + v1[1] * v1[1]) + (v1[2] * v1[2] + v1[3] * v1[3]);
                }
                ss += __shfl_xor(ss, 16); ss += __shfl_xor(ss, 32);
                if (fq == 0) ssp[(size_t)row * 16 + u.pn * 4 + wc] = ss;
            }
    }
};

struct CvtJob { const float* src; int K, N, ldsrc, src_col0; bf16_t* dst; int ldt, row0, col0; const float* kscale; int Kpad; };
__device__ __forceinline__ int cvt_items(const CvtJob& j) { return (j.Kpad / 64) * (j.N / 32); }
__device__ __forceinline__ void cvt_item(const CvtJob& j, LAS float* scr, int item, int lane) {
    const int nblk = j.N / 32, kb = item / nblk, nb = item % nblk, k0 = 64 * kb, n0 = 32 * nb;
#pragma unroll 8
    for (int i = 0; i < 32; ++i) { const int kk = 2 * i + (lane >> 5), k = k0 + kk; float v = 0.f;
        if (j.src && k < j.K) { v = j.src[(size_t)k * j.ldsrc + j.src_col0 + n0 + (lane & 31)]; if (j.kscale) v *= j.kscale[k]; }
        scr[kk * 33 + (lane & 31)] = v; }
    asm volatile("s_waitcnt lgkmcnt(0)" ::: "memory");
    const int c = lane & 7;
#pragma unroll
    for (int jj = 0; jj < 4; ++jj) { const int n = (lane >> 3) + 8 * jj; const LAS float* s = scr + (8 * c) * 33 + n;
        u32x4 o; o.x = pk2(s[0 * 33], s[1 * 33]); o.y = pk2(s[2 * 33], s[3 * 33]); o.z = pk2(s[4 * 33], s[5 * 33]); o.w = pk2(s[6 * 33], s[7 * 33]);
        *(u32x4*)(j.dst + (size_t)(j.row0 + n0 + n) * j.ldt + j.col0 + k0 + 8 * c) = o; }
    asm volatile("s_waitcnt lgkmcnt(0)" ::: "memory");
}

struct Params {
    const float* in[38]; float* out; unsigned char* ws;
};
constexpr size_t MiB = 1u << 20;
constexpr size_t WS_CTL = 0;
constexpr size_t WS_ROPE = 1 * MiB;
constexpr size_t WS_SSP = 2 * MiB;
constexpr size_t WS_SSP2 = 3 * MiB;
constexpr size_t WS_WUP = 5 * MiB;
constexpr size_t WS_WDN = 16 * MiB;
constexpr size_t WS_XB = 22 * MiB;
constexpr size_t WS_WMIX = 54 * MiB;
constexpr size_t WS_SCR = 88 * MiB;
constexpr size_t WS_U = WS_SCR;
constexpr size_t WS_ACT = WS_SCR + 176 * MiB;
constexpr size_t WS_END = 352 * MiB;
static_assert(WS_ACT + (size_t)MTOK * FFN * 2 <= WS_END, "ws map");
constexpr size_t WM_QKV0 = WS_WMIX, WM_OA0 = WS_WMIX + 3 * MiB, WM_QKV1 = WS_WMIX + 5 * MiB, WM_OA1 = WS_WMIX + 8 * MiB;
constexpr size_t WM_BIG = WS_WMIX + 10 * MiB;
constexpr size_t WM_W2T = WS_WMIX + 25 * MiB;
constexpr size_t WM_A2T = WM_W2T + 256 * 1024;
constexpr size_t WM_G2 = WM_W2T + 512 * 1024;
constexpr size_t WM_OB = WS_WMIX + 26 * MiB;
constexpr size_t WM_DOWN = WS_WMIX + 28 * MiB;
constexpr size_t WM_UQ = WM_DOWN + 1536 * 1024;
constexpr size_t WM_UKV = WM_UQ + 1152 * 1024;
constexpr size_t WM_OC = WS_WMIX + 32 * MiB;
static_assert(WM_UKV + 1024 * 1024 <= WM_OC && WM_OC + 2 * MiB <= WS_SCR, "mixer weight map");

__device__ __forceinline__ void ffn_weights_phase(const Params& P, int layer, LAS unsigned char* lds, int gw, int ngw, int wave, int lane) {
    LAS float* scr = (LAS float*)(lds + wave * 16384);
    CvtJob up{P.in[3] + (size_t)layer * 1024 * FF2, 1024, FF2, FF2, 0, (bf16_t*)(P.ws + WS_WUP), 1024, 0, 0, P.in[2] + layer * DM, 1024};
    CvtJob dn{P.in[6] + (size_t)layer * FFN * 1024, FFN, 1024, 1024, 0, (bf16_t*)(P.ws + WS_WDN), FFN, 0, 0, nullptr, FFN};
    const int n1 = cvt_items(up), n2 = cvt_items(dn);
    for (int it = gw; it < n1 + n2; it += ngw) { if (it < n1) cvt_item(up, scr, it, lane); else cvt_item(dn, scr, it - n1, lane); }
}

__device__ __forceinline__ void rownorm_phase(const float* x, bf16_t* xb, float* ssp, int rows, int gw, int ngw, int lane) {
    for (int r = gw; r < rows; r += ngw) {
        const f32x4* xr = (const f32x4*)(x + (size_t)r * DM) + lane; float s = 0.f;
        unsigned long long* o8 = (unsigned long long*)(xb + (size_t)r * DM) + lane;
#pragma unroll
        for (int j = 0; j < 4; ++j) { const f32x4 v = xr[64 * j]; s += (v[0] * v[0] + v[1] * v[1]) + (v[2] * v[2] + v[3] * v[3]);
            o8[64 * j] = (unsigned long long)pk2(v[0], v[1]) | ((unsigned long long)pk2(v[2], v[3]) << 32); }
        s = wave_sum(s);
        if (lane < 16) ssp[(size_t)r * 16 + lane] = (lane == 0) ? s : 0.f;
    }
}

__device__ __forceinline__ void ffn_conv_phase(const bf16_t* U, const float* cw, const float* cb, bf16_t* ACT, int rows, int gtid, int ngt) {
    const int ncg = FFN / 8; const long nitems = (long)(rows / 16) * ncg;
    for (long it = gtid; it < nitems; it += ngt) {
        const int cg = (int)(it % ncg), rb = (int)(it / ncg), f0 = cg * 8, r0 = rb * 16;
        float w[2][3][8], bias[2][8];
#pragma unroll
        for (int h = 0; h < 2; ++h) {
#pragma unroll
            for (int t = 0; t < 3; ++t) { const f32x4 a = *(const f32x4*)(cw + t * FF2 + h * FFN + f0), b = *(const f32x4*)(cw + t * FF2 + h * FFN + f0 + 4);
#pragma unroll
                for (int e = 0; e < 4; ++e) { w[h][t][e] = a[e]; w[h][t][4 + e] = b[e]; } }
            const f32x4 a = *(const f32x4*)(cb + h * FFN + f0), b = *(const f32x4*)(cb + h * FFN + f0 + 4);
#pragma unroll
            for (int e = 0; e < 4; ++e) { bias[h][e] = a[e]; bias[h][4 + e] = b[e]; }
        }
        float prev[2][8], cur[2][8], nxt[2][8];
        auto loadrow = [&](int r, float (&dst)[2][8], bool valid) {
#pragma unroll
            for (int h = 0; h < 2; ++h) {
                u32x4 v = (u32x4){0u, 0u, 0u, 0u};
                if (valid) v = *(const u32x4*)(U + (size_t)r * FF2 + h * FFN + f0);
#pragma unroll
                for (int e = 0; e < 4; ++e) { dst[h][2 * e] = __builtin_bit_cast(float, v[e] << 16); dst[h][2 * e + 1] = __builtin_bit_cast(float, v[e] & 0xffff0000u); }
            }
        };
        loadrow(r0 - 1, prev, (r0 % SEQ) != 0);
        loadrow(r0, cur, true);
#pragma unroll
        for (int i = 0; i < 16; ++i) {
            const int r = r0 + i;
            loadrow(r + 1, nxt, ((r + 1) % SEQ) != 0);
            float o[8];
#pragma unroll
            for (int e = 0; e < 8; ++e) {
                const float g = bias[0][e] + prev[0][e] * w[0][0][e] + cur[0][e] * w[0][1][e] + nxt[0][e] * w[0][2][e];
                const float v = bias[1][e] + prev[1][e] * w[1][0][e] + cur[1][e] * w[1][1][e] + nxt[1][e] * w[1][2][e];
                o[e] = g / (1.f + __expf(-g)) * v;
            }
            u32x4 pk; pk.x = pk2(o[0], o[1]); pk.y = pk2(o[2], o[3]); pk.z = pk2(o[4], o[5]); pk.w = pk2(o[6], o[7]);
            *(u32x4*)(ACT + (size_t)r * FFN + f0) = pk;
#pragma unroll
            for (int h = 0; h < 2; ++h)
#pragma unroll
                for (int e = 0; e < 8; ++e) { prev[h][e] = cur[h][e]; cur[h][e] = nxt[h][e]; }
        }
    }
}


typedef short bf16x8 __attribute__((ext_vector_type(8)));
typedef float f32x16 __attribute__((ext_vector_type(16)));
typedef unsigned u32x2 __attribute__((ext_vector_type(2)));
#define MFMA32(a, b, c) __builtin_amdgcn_mfma_f32_32x32x16_bf16((a), (b), (c), 0, 0, 0)
__device__ __forceinline__ int crow(int r, int hi) { return (r & 3) + 8 * (r >> 2) + 4 * hi; }
constexpr float LOG2E = 1.4426950408889634f;

template <int DQK, int NQ, bool MASK>
__device__ __forceinline__ void attn_unit(LAS unsigned char* lds, const bf16_t* Kt, const bf16_t* Vt, int kt0, int kt1,
                                          const bf16_t* Qp, int qld, const int (&qtok)[NQ], const int (&qpos)[NQ], int qcol, float m0, float l0, bf16_t* O, int ocol) {
    constexpr int KROW = DQK * 2 + 16, KB = 64 * KROW, VB = 64 * 136, KCH = 64 * DQK / 8, ND = DQK / 16;
    const int tid = opaque_tid(), lane = tid & 63, r32 = lane & 31, hi = lane >> 5;
    bf16x8 qf[NQ][ND];
#pragma unroll
    for (int qt = 0; qt < NQ; ++qt)
#pragma unroll
        for (int d0 = 0; d0 < ND; ++d0) qf[qt][d0] = *(const bf16x8*)(Qp + (size_t)(qtok[qt] + r32) * qld + qcol + 16 * d0 + 8 * hi);
    float m[NQ], l[NQ]; f32x16 o[NQ][2];
#pragma unroll
    for (int qt = 0; qt < NQ; ++qt) { m[qt] = m0; l[qt] = (hi == 0) ? l0 : 0.f;
#pragma unroll
        for (int r = 0; r < 16; ++r) { o[qt][0][r] = 0.f; o[qt][1][r] = 0.f; } }
    u32x4 kreg[2], vreg; const int vdv = tid >> 3, vpart = tid & 7;
#define ATT_GLOAD(t) do { _Pragma("unroll") for (int i_ = 0; i_ < 2; ++i_) { const int c_ = tid + 512 * i_; if (c_ < KCH) kreg[i_] = *(const u32x4*)(Kt + (size_t)(t) * 64 * DQK + c_ * 8); } \
        vreg = *(const u32x4*)(Vt + (size_t)vdv * SEQ + (t) * 64 + vpart * 8); } while (0)
#define ATT_LWRITE(buf) do { _Pragma("unroll") for (int i_ = 0; i_ < 2; ++i_) { const int c_ = tid + 512 * i_; if (c_ < KCH) { const int key_ = c_ / (DQK / 8), part_ = c_ % (DQK / 8); \
            *(LAS u32x4*)(lds + (buf) * KB + key_ * KROW + part_ * 16) = kreg[i_]; } } \
        LAS unsigned char* vp_ = lds + 2 * KB + (buf) * VB + vdv * 136 + vpart * 16; *(LAS u32x2*)vp_ = (u32x2){vreg[0], vreg[1]}; *(LAS u32x2*)(vp_ + 8) = (u32x2){vreg[2], vreg[3]}; } while (0)
    ATT_GLOAD(kt0); ATT_LWRITE(0); __syncthreads();
    for (int t = kt0; t <= kt1; ++t) {
        const int buf = (t - kt0) & 1;
        if (t < kt1) ATT_GLOAD(t + 1);
#pragma unroll
        for (int qt = 0; qt < NQ; ++qt) {
            f32x16 p0, p1;
#pragma unroll
            for (int r = 0; r < 16; ++r) { p0[r] = 0.f; p1[r] = 0.f; }
            const LAS unsigned char* kb = lds + buf * KB + r32 * KROW + hi * 16;
#pragma unroll
            for (int d0 = 0; d0 < ND; ++d0) {
                const bf16x8 k0 = *(const LAS bf16x8*)(kb + d0 * 32), k1 = *(const LAS bf16x8*)(kb + 32 * KROW + d0 * 32);
                p0 = MFMA32(k0, qf[qt][d0], p0); p1 = MFMA32(k1, qf[qt][d0], p1);
            }
            if (MASK) { const int qp = qpos[qt] + r32;
#pragma unroll
                for (int r = 0; r < 16; ++r) { const int d = qp - (64 * t + crow(r, hi)); if (d > 128 || d < -128) p0[r] = -1e30f; if (d - 32 > 128 || d - 32 < -128) p1[r] = -1e30f; } }
            float mx = fmaxf(p0[0], p1[0]);
#pragma unroll
            for (int r = 1; r < 16; ++r) mx = fmaxf(mx, fmaxf(p0[r], p1[r]));
            mx = fmaxf(mx, __shfl_xor(mx, 32));
            const float mn = fmaxf(m[qt], mx), alpha = __builtin_amdgcn_exp2f(m[qt] - mn); m[qt] = mn;
            float ls = 0.f;
#pragma unroll
            for (int r = 0; r < 16; ++r) { p0[r] = __builtin_amdgcn_exp2f(p0[r] - mn); p1[r] = __builtin_amdgcn_exp2f(p1[r] - mn); ls += p0[r] + p1[r]; }
            l[qt] = l[qt] * alpha + ls;
#pragma unroll
            for (int r = 0; r < 16; ++r) { o[qt][0][r] *= alpha; o[qt][1][r] *= alpha; }
            bf16x8 pf[2][2];
#pragma unroll
            for (int s2 = 0; s2 < 2; ++s2) {
                u32x4 a, b;
#pragma unroll
                for (int j = 0; j < 4; ++j) { a[j] = pk2(p0[8 * s2 + 2 * j], p0[8 * s2 + 2 * j + 1]); b[j] = pk2(p1[8 * s2 + 2 * j], p1[8 * s2 + 2 * j + 1]); }
                pf[0][s2] = __builtin_bit_cast(bf16x8, a); pf[1][s2] = __builtin_bit_cast(bf16x8, b);
            }
#pragma unroll
            for (int dvb = 0; dvb < 2; ++dvb) {
                const LAS unsigned char* vb = lds + 2 * KB + buf * VB + (r32 + 32 * dvb) * 136 + hi * 8;
#pragma unroll
                for (int kb2 = 0; kb2 < 2; ++kb2)
#pragma unroll
                    for (int s2 = 0; s2 < 2; ++s2) {
                        const u32x2 a = *(const LAS u32x2*)(vb + kb2 * 64 + s2 * 32), b = *(const LAS u32x2*)(vb + kb2 * 64 + s2 * 32 + 16);
                        const u32x4 vv = (u32x4){a[0], a[1], b[0], b[1]};
                        o[qt][dvb] = MFMA32(__builtin_bit_cast(bf16x8, vv), pf[kb2][s2], o[qt][dvb]);
                    }
            }
        }
        if (t < kt1) ATT_LWRITE(buf ^ 1);
        __syncthreads();
    }
#undef ATT_GLOAD
#undef ATT_LWRITE
#pragma unroll
    for (int qt = 0; qt < NQ; ++qt) {
        const float lt = l[qt] + __shfl_xor(l[qt], 32), inv = 1.f / lt;
        bf16_t* orow = O + (size_t)(qtok[qt] + r32) * DM + ocol;
#pragma unroll
        for (int dvb = 0; dvb < 2; ++dvb)
#pragma unroll
            for (int g = 0; g < 4; ++g) {
                u32x2 w; w[0] = pk2(o[qt][dvb][4 * g] * inv, o[qt][dvb][4 * g + 1] * inv); w[1] = pk2(o[qt][dvb][4 * g + 2] * inv, o[qt][dvb][4 * g + 3] * inv);
                *(u32x2*)(orow + 32 * dvb + 8 * g + 4 * hi) = w;
            }
    }
}

__device__ __forceinline__ void swa_attn_phase(LAS unsigned char* lds, const bf16_t* Qp, const bf16_t* Kp, const bf16_t* Vt, const float* sinks, bf16_t* O, int nbat, int vcu, int G, int wave) {
    const int nunits = nbat * 4 * 16 * 2;
    for (int u = vcu; u < nunits; u += G) {
        const int sub = u & 1, nb = (u >> 1) % 16, hk = (u >> 5) % 4, b = u >> 7;
        const int t16 = sub * 8 + wave, head = hk * 4 + (t16 >> 2);
        const int qp0 = nb * 128 + (t16 & 3) * 32; const int qpos[1] = {qp0}; const int qtok[1] = {b * SEQ + qp0};
        const int kt0 = max(0, 2 * nb - 2), kt1 = min(SEQ / 64 - 1, 2 * nb + 3);
        attn_unit<64, 1, true>(lds, Kp + (size_t)(b * 4 + hk) * SEQ * 64, Vt + (size_t)(b * 4 + hk) * 64 * SEQ, kt0, kt1, Qp, 1024, qtok, qpos, head * 64, sinks[head] * LOG2E, 1.f, O, head * 64);
    }
}
__device__ __forceinline__ void mla_attn_phase(LAS unsigned char* lds, const bf16_t* Qp, const bf16_t* Kp, const bf16_t* Vt, bf16_t* O, int nbat, int vcu, int G, int wave) {
    const int nunits = nbat * 16 * 8;
    for (int u = vcu; u < nunits; u += G) {
        const int qb = u % 8, h = (u / 8) % 16, b = u / 128;
        const int qp0 = qb * 256 + wave * 32; const int qpos[1] = {qp0}; const int qtok[1] = {b * SEQ + qp0};
        attn_unit<96, 1, false>(lds, Kp + (size_t)(b * 16 + h) * SEQ * 96, Vt + (size_t)(b * 16 + h) * 64 * SEQ, 0, SEQ / 64 - 1, Qp, 1536, qtok, qpos, h * 96, -1e30f, 0.f, O, h * 64);
    }
}

__device__ __forceinline__ void swa_prep_phase(const bf16_t* QKV, const float* qg, const float* kg, const float* cosA, const float* sinA, bf16_t* Qp, bf16_t* Kp, bf16_t* Vt, int rows, int gw, int ngw, int lane) {
    const long nh = (long)rows * 20;
    for (long it = gw; it < nh; it += ngw) {
        const int tok = (int)(it / 20), hh = (int)(it % 20), s = tok % SEQ, b = tok / SEQ;
        float v = bf2f(QKV[(size_t)tok * 1536 + hh * 64 + lane]);
        const float ss = wave_sum(v * v), r = rsqrtf(ss * (1.f / 64.f) + NORM_EPS);
        v = v * r * ((hh < 16) ? qg[lane] : kg[lane]);
        const float other = __shfl_xor(v, 8);
        if (lane < 16) { const float c = cosA[s * 8 + (lane & 7)], sn = sinA[s * 8 + (lane & 7)]; v = (lane < 8) ? (v * c - other * sn) : (v * c + other * sn); }
        if (hh < 16) Qp[(size_t)tok * 1024 + hh * 64 + lane] = (bf16_t)f2bf(v * (0.125f * LOG2E));
        else Kp[((size_t)(b * 4 + hh - 16) * SEQ + s) * 64 + lane] = (bf16_t)f2bf(v);
    }
    const int nv = (rows / 64) * 4;
    for (int it = gw; it < nv; it += ngw) {
        const int hk = it % 4, tb = it / 4, tok = tb * 64 + lane, s = tok % SEQ, b = tok / SEQ;
#pragma unroll
        for (int c = 0; c < 8; ++c) {
            const u32x4 v = *(const u32x4*)(QKV + (size_t)tok * 1536 + 1280 + hk * 64 + 8 * c);
            bf16_t* dst = Vt + ((size_t)(b * 4 + hk) * 64 + 8 * c) * SEQ + s;
#pragma unroll
            for (int e = 0; e < 4; ++e) { dst[(size_t)(2 * e) * SEQ] = (bf16_t)(v[e] & 0xffffu); dst[(size_t)(2 * e + 1) * SEQ] = (bf16_t)(v[e] >> 16); }
        }
    }
}
__device__ __forceinline__ void mla_prep_phase(bf16_t* Q, const bf16_t* KV, const bf16_t* DOWN, const float* qg, const float* kg, const float* cosC, const float* sinC, bf16_t* Kp, bf16_t* Vt, int rows, int gw, int ngw, int lane) {
    const long nh = (long)rows * 32;
    for (long it = gw; it < nh; it += ngw) {
        const int tok = (int)(it / 32), hh = (int)(it % 32), h = hh & 15, s = tok % SEQ, b = tok / SEQ; const bool isk = hh >= 16;
        float lo, hi2 = 0.f;
        if (!isk) { const bf16_t* p = Q + (size_t)tok * 1536 + h * 96; lo = bf2f(p[lane]); if (lane < 32) hi2 = bf2f(p[64 + lane]); }
        else { lo = bf2f(KV[(size_t)tok * 2048 + h * 128 + lane]); if (lane < 32) hi2 = bf2f(DOWN[(size_t)tok * 768 + 384 + lane]); }
        const float* g = isk ? kg : qg;
        const float ss = wave_sum(lo * lo + hi2 * hi2), r = rsqrtf(ss * (1.f / 96.f) + NORM_EPS);
        lo = lo * r * g[lane]; if (lane < 32) hi2 = hi2 * r * g[64 + lane];
        const float other = __shfl_xor(hi2, 16);
        const float c = cosC[s * 16 + (lane & 15)], sn = sinC[s * 16 + (lane & 15)];
        float hin = hi2;
        if (lane < 16) hin = hi2 * c - other * sn; else if (lane < 32) hin = hi2 * c + other * sn;
        if (!isk) { const float sc = 0.10206207261596577f * LOG2E; bf16_t* p = Q + (size_t)tok * 1536 + h * 96; p[lane] = (bf16_t)f2bf(lo * sc); if (lane < 32) p[64 + lane] = (bf16_t)f2bf(hin * sc); }
        else { bf16_t* p = Kp + ((size_t)(b * 16 + h) * SEQ + s) * 96; p[lane] = (bf16_t)f2bf(lo); if (lane < 32) p[64 + lane] = (bf16_t)f2bf(hin); }
    }
    const int nv = (rows / 64) * 16;
    for (int it = gw; it < nv; it += ngw) {
        const int h = it % 16, tb = it / 16, tok = tb * 64 + lane, s = tok % SEQ, b = tok / SEQ;
#pragma unroll
        for (int c = 0; c < 8; ++c) {
            const u32x4 v = *(const u32x4*)(KV + (size_t)tok * 2048 + h * 128 + 64 + 8 * c);
            bf16_t* dst = Vt + ((size_t)(b * 16 + h) * 64 + 8 * c) * SEQ + s;
#pragma unroll
            for (int e = 0; e < 4; ++e) { dst[(size_t)(2 * e) * SEQ] = (bf16_t)(v[e] & 0xffffu); dst[(size_t)(2 * e + 1) * SEQ] = (bf16_t)(v[e] >> 16); }
        }
    }
}
__device__ __forceinline__ void rope_phase(float* tab, int gtid, int ngt) {
    for (int idx = gtid; idx < SEQ * 24; idx += ngt) {
        const int s = idx / 24, j = idx % 24;
        if (j < 8) { const float inv = (float)pow(500000.0, -(double)(2 * j) / 16.0), ang = (float)s * inv; tab[s * 8 + j] = (float)cos((double)ang); tab[SEQ * 8 + s * 8 + j] = (float)sin((double)ang); }
        else { const int i = j - 8; const float inv = (float)pow(500000.0, -(double)(2 * i) / 32.0), ang = (float)s * inv; tab[SEQ * 16 + s * 16 + i] = (float)cos((double)ang); tab[SEQ * 32 + s * 16 + i] = (float)sin((double)ang); }
    }
}
__device__ __forceinline__ int mixer_njobs(int kind) { return kind == 0 ? 2 : (kind == 1 ? 22 : 7); }
__device__ __forceinline__ CvtJob mixer_job(const Params& P, int layer, int j) {
    const int kind = layer % 3, jj = layer / 3; unsigned char* ws = P.ws;
    CvtJob z{nullptr, 0, 32, 0, 0, (bf16_t*)ws, 64, 0, 0, nullptr, 64};
    if (kind == 0) {
        if (j == 0) return CvtJob{P.in[7] + (size_t)jj * 1024 * 1536, 1024, 1536, 1536, 0, (bf16_t*)(ws + (jj ? WM_QKV1 : WM_QKV0)), 1024, 0, 0, P.in[1] + layer * DM, 1024};
        return CvtJob{P.in[11] + (size_t)jj * 1024 * 1024, 1024, 1024, 1024, 0, (bf16_t*)(ws + (jj ? WM_OA1 : WM_OA0)), 1024, 0, 0, nullptr, 1024};
    } else if (kind == 1) {
        const float* mu = P.in[12]; bf16_t* big = (bf16_t*)(ws + WM_BIG);
        switch (j) {
        case 0: return CvtJob{P.in[13], 1024, 1024, 1024, 0, big, 2048, 0, 0, nullptr, 1024};
        case 1: return CvtJob{P.in[13], 1024, 1024, 1024, 0, big, 2048, 0, 1024, mu + 0 * 1024, 1024};
        case 2: return CvtJob{P.in[14], 1024, 1024, 1024, 0, big, 2048, 1024, 0, nullptr, 1024};
        case 3: return CvtJob{P.in[14], 1024, 1024, 1024, 0, big, 2048, 1024, 1024, mu + 2 * 1024, 1024};
        case 4: return CvtJob{P.in[15], 1024, 1024, 1024, 0, big, 2048, 2048, 0, nullptr, 1024};
        case 5: return CvtJob{P.in[15], 1024, 1024, 1024, 0, big, 2048, 2048, 1024, mu + 3 * 1024, 1024};
        case 6: return CvtJob{P.in[17], 1024, 64, 64, 0, big, 2048, 3072, 0, nullptr, 1024};
        case 7: return CvtJob{P.in[17], 1024, 64, 64, 0, big, 2048, 3072, 1024, mu + 1 * 1024, 1024};
        case 8: return CvtJob{P.in[17] + 65536, 1024, 64, 64, 0, big, 2048, 3136, 0, nullptr, 1024};
        case 9: return CvtJob{P.in[17] + 65536, 1024, 64, 64, 0, big, 2048, 3136, 1024, mu + 1 * 1024, 1024};
        case 10: return CvtJob{nullptr, 0, 128, 0, 0, big, 2048, 3200, 0, nullptr, 2048};
        case 11: return CvtJob{P.in[20], 1024, 64, 64, 0, big, 2048, 3328, 0, nullptr, 1024};
        case 12: return CvtJob{P.in[20], 1024, 64, 64, 0, big, 2048, 3328, 1024, mu + 4 * 1024, 1024};
        case 13: return CvtJob{P.in[20] + 65536, 1024, 64, 64, 0, big, 2048, 3392, 0, nullptr, 1024};
        case 14: return CvtJob{P.in[20] + 65536, 1024, 64, 64, 0, big, 2048, 3392, 1024, mu + 4 * 1024, 1024};
        case 15: return CvtJob{nullptr, 0, 128, 0, 0, big, 2048, 3456, 0, nullptr, 2048};
        case 16: return CvtJob{P.in[22], 1024, 160, 160, 0, big, 2048, 3584, 0, nullptr, 1024};
        case 17: return CvtJob{P.in[22], 1024, 160, 160, 0, big, 2048, 3584, 1024, mu + 5 * 1024, 1024};
        case 18: return CvtJob{nullptr, 0, 96, 0, 0, big, 2048, 3744, 0, nullptr, 2048};
        case 19: return CvtJob{P.in[23], 160, 1024, 1024, 0, (bf16_t*)(ws + WM_G2), 256, 0, 0, nullptr, 256};
        case 20: return CvtJob{P.in[29], 1024, 1024, 1024, 0, (bf16_t*)(ws + WM_OB), 1024, 0, 0, nullptr, 1024};
        default: return z;
        }
    } else {
        const float* gt = P.in[1] + layer * DM; bf16_t* dn = (bf16_t*)(ws + WM_DOWN);
        switch (j) {
        case 0: return CvtJob{P.in[30], 1024, 384, 672, 0, dn, 1024, 0, 0, gt, 1024};
        case 1: return CvtJob{P.in[30], 1024, 32, 672, 640, dn, 1024, 384, 0, gt, 1024};
        case 2: return CvtJob{nullptr, 0, 96, 0, 0, dn, 1024, 416, 0, nullptr, 1024};
        case 3: return CvtJob{P.in[30], 1024, 256, 672, 384, dn, 1024, 512, 0, gt, 1024};
        case 4: return CvtJob{P.in[33], 384, 1536, 1536, 0, (bf16_t*)(ws + WM_UQ), 384, 0, 0, P.in[31], 384};
        case 5: return CvtJob{P.in[34], 256, 2048, 2048, 0, (bf16_t*)(ws + WM_UKV), 256, 0, 0, P.in[32], 256};
        default: return CvtJob{P.in[37], 1024, 1024, 1024, 0, (bf16_t*)(ws + WM_OC), 1024, 0, 0, nullptr, 1024};
        }
    }
}
__device__ __forceinline__ CvtJob mixer_job_small(const Params& P, int q) {
    const int d = q & 1; const bool isa = q >= 2;
    return CvtJob{(isa ? P.in[21] : P.in[18]) + (size_t)d * 64 * 1024, 64, 1024, 1024, 0, (bf16_t*)(P.ws + (isa ? WM_A2T : WM_W2T)) + (size_t)d * 1024 * 64, 64, 0, 0, nullptr, 64};
}
__device__ __forceinline__ void mixer_weights_phase(const Params& P, int layer, LAS unsigned char* lds, int gw, int ngw, int wave, int lane) {
    LAS float* scr = (LAS float*)(lds + wave * 16384);
    const int kind = layer % 3, nj = mixer_njobs(kind);
    int it = gw, base = 0;
    for (int j = 0; j < nj; ++j) {
        if (kind == 1 && j == 21) {
            for (int q = 0; q < 4; ++q) { const CvtJob jb = mixer_job_small(P, q); const int n = cvt_items(jb); while (it < base + n) { cvt_item(jb, scr, it - base, lane); it += ngw; } base += n; }
        } else { const CvtJob jb = mixer_job(P, layer, j); const int n = cvt_items(jb); while (it < base + n) { cvt_item(jb, scr, it - base, lane); it += ngw; } base += n; }
    }
}


__device__ __forceinline__ void rwkv_premix_phase(const float* x, const float* ssp, const float* g, bf16_t* HX, int rows, int gw, int ngw, int lane) {
    const int nitems = (rows / 16) * 2;
    for (int it = gw; it < nitems; it += ngw) {
        const int half = it & 1, r0 = (it >> 1) * 16, c0 = half * 512 + lane * 8;
        float rs = 0.f;
        { const int rr = r0 - 1 + lane; if (lane < 18 && rr >= 0 && rr < rows) { const float* p = ssp + (size_t)rr * 16; float sm = 0.f;
#pragma unroll
              for (int i = 0; i < 16; i += 4) { const f32x4 v = *(const f32x4*)(p + i); sm += (v[0] + v[1]) + (v[2] + v[3]); }
              rs = rsqrtf(sm * (1.f / 1024.f) + NORM_EPS); } }
        float gg[8]; { const f32x4 a = *(const f32x4*)(g + c0), b = *(const f32x4*)(g + c0 + 4);
#pragma unroll
            for (int e = 0; e < 4; ++e) { gg[e] = a[e]; gg[4 + e] = b[e]; } }
        float prev[8], cur[8], nxt[8];
        auto loadrow = [&](int r, float (&dst)[8], bool valid, float rstd) {
            f32x4 a = (f32x4){0.f, 0.f, 0.f, 0.f}, b = a;
            if (valid) { a = *(const f32x4*)(x + (size_t)r * DM + c0); b = *(const f32x4*)(x + (size_t)r * DM + c0 + 4); }
#pragma unroll
            for (int e = 0; e < 4; ++e) { dst[e] = a[e] * rstd * gg[e]; dst[4 + e] = b[e] * rstd * gg[4 + e]; }
        };
        loadrow(r0 - 1, prev, (r0 % SEQ) != 0, __shfl(rs, 0));
        loadrow(r0, cur, true, __shfl(rs, 1));
#pragma unroll
        for (int i = 0; i < 16; ++i) {
            const int r = r0 + i;
            loadrow(r + 1, nxt, ((r + 1) % SEQ) != 0, __shfl(rs, i + 2));
            float xx[8];
#pragma unroll
            for (int e = 0; e < 8; ++e) xx[e] = 0.5f * (prev[e] + nxt[e]) - cur[e];
            u32x4 ph, px; ph.x = pk2(cur[0], cur[1]); ph.y = pk2(cur[2], cur[3]); ph.z = pk2(cur[4], cur[5]); ph.w = pk2(cur[6], cur[7]);
            px.x = pk2(xx[0], xx[1]); px.y = pk2(xx[2], xx[3]); px.z = pk2(xx[4], xx[5]); px.w = pk2(xx[6], xx[7]);
            *(u32x4*)(HX + (size_t)r * 2048 + c0) = ph; *(u32x4*)(HX + (size_t)r * 2048 + 1024 + c0) = px;
#pragma unroll
            for (int e = 0; e < 8; ++e) { prev[e] = cur[e]; cur[e] = nxt[e]; }
        }
    }
}
struct EpiRwkvBig {
    static constexpr bool PERM = true, AFTER_DRAIN = false;
    unsigned short* RKV; size_t rkv_stride; bf16_t* L1;
    template <int MODE  > __device__ __forceinline__ void tile(const f32x4 (&acc)[2][2][4][2], unsigned short* dst0, int ld, int row0, int cc0) const {
#pragma unroll
        for (int ai = 0; ai < 2; ++ai)
#pragma unroll
            for (int m = 0; m < 4; ++m) {
                unsigned short* dr = dst0 + (size_t)(row0 + ai * 128 + m * 16) * ld + cc0;
#pragma unroll
                for (int bj = 0; bj < 2; ++bj) {
                    f32x4 v0 = acc[ai][bj][m][0], v1 = acc[ai][bj][m][1]; u32x4 w;
                    if (MODE == 0) { w.x = pkh2(v0[0], v0[1]); w.y = pkh2(v0[2], v0[3]); w.z = pkh2(v1[0], v1[1]); w.w = pkh2(v1[2], v1[3]); }
                    else {
                        if (MODE == 1) {
#pragma unroll
                            for (int e = 0; e < 4; ++e) { v0[e] = 1.f - 2.f / (1.f + __expf(2.f * v0[e])); v1[e] = 1.f - 2.f / (1.f + __expf(2.f * v1[e])); } }
                        if (MODE == 3) {
#pragma unroll
                            for (int e = 0; e < 4; ++e) { v0[e] = 1.f / (1.f + __expf(-v0[e])); v1[e] = 1.f / (1.f + __expf(-v1[e])); } }
                        w.x = pk2(v0[0], v0[1]); w.y = pk2(v0[2], v0[3]); w.z = pk2(v1[0], v1[1]); w.w = pk2(v1[2], v1[3]);
                    }
                    *(u32x4*)(dr + bj * 128) = w;
                }
            }
    }
    __device__ __forceinline__ void operator()(const f32x4 (&acc)[2][2][4][2], const Unit& u, int wr, int wc, int fr, int fq) const {
        const int pn = u.pn, row0 = u.pm * 256 + wr * 64 + fr, cc = wc * 32 + 8 * fq;
        if (pn < 12) tile<0>(acc, RKV + (size_t)(pn >> 2) * rkv_stride, 1024, row0, (pn & 3) * 256 + cc);
        else if (pn == 12) tile<1>(acc, (unsigned short*)L1, 768, row0, cc);
        else if (pn == 13) tile<2>(acc, (unsigned short*)L1, 768, row0, 256 + cc);
        else tile<3>(acc, (unsigned short*)L1, 768, row0, 512 + cc);
    }
};

template <int CTRL> __device__ __forceinline__ float dpp_f(float v) { return __builtin_bit_cast(float, __builtin_amdgcn_update_dpp(0, __builtin_bit_cast(int, v), CTRL, 0xf, 0xf, true)); }
__device__ __forceinline__ float red8(float v) { v += dpp_f<0xB1>(v); v += dpp_f<0x4E>(v); v += dpp_f<0x141>(v); return v; }
__device__ __forceinline__ float red16(float v) { v = red8(v); v += dpp_f<0x140>(v); return v; }
__device__ __forceinline__ float h2f(unsigned short h) { return (float)__builtin_bit_cast(_Float16, h); }
constexpr int SC_T = 64;
constexpr int SC_AN = 0, SC_WR = 16384, SC_W = 32768, SC_BB = 49152, SC_KD = 65536, SC_V = 81920, SC_Y = 98304, SC_SCAL = 114688;
struct ScanTensors { const unsigned short* R; const unsigned short* K; const unsigned short* V; const bf16_t* L1; const bf16_t* W2T; const bf16_t* A2T;
                     const float* w0; const float* a0; const float* k_k; const float* k_a; const float* r_k; bf16_t* Y  ; float* BON  ; int rows; };
__device__ __forceinline__ void rwkv_scan_unit(LAS unsigned char* lds, const ScanTensors& T, int b, int h, int dir) {
    const int tid = opaque_tid(), lane = tid & 63, wave = __builtin_amdgcn_readfirstlane(tid >> 6), r32 = lane & 31, hi = lane >> 5;
    const int ks = lane & 15, slot = lane >> 4, v0 = wave * 8 + slot * 2;
    const int q = wave >> 2, mt = (wave >> 1) & 1, nt = wave & 1;
    bf16x8 bfrag[4];
    { const bf16_t* wt = (q ? T.A2T : T.W2T) + ((size_t)dir * 1024 + h * 64 + 32 * nt + r32) * 64 + 8 * hi;
#pragma unroll
      for (int s2 = 0; s2 < 4; ++s2) bfrag[s2] = *(const bf16x8*)(wt + 16 * s2); }
    const float bias0 = (q ? T.a0 : T.w0)[dir * 1024 + h * 64 + 32 * nt + r32];
    const int bi = tid >> 3, cb = (tid & 7) * 8;
    float kkc[8], kac[8], rkc[8];
#pragma unroll
    for (int e = 0; e < 8; ++e) { kkc[e] = T.k_k[h * 64 + cb + e]; kac[e] = T.k_a[h * 64 + cb + e]; rkc[e] = T.r_k[h * 64 + cb + e]; }
    f32x4 S0 = (f32x4){0.f, 0.f, 0.f, 0.f}, S1 = S0;
    const int nchunks = SEQ / SC_T;
    for (int c = 0; c < nchunks; ++c) {
        const int tbase = b * SEQ;
        {
            f32x16 acc;
#pragma unroll
            for (int r = 0; r < 16; ++r) acc[r] = 0.f;
            const int ia = 32 * mt + r32;
            const int tok = tbase + (dir ? (SEQ - 1 - (c * SC_T + ia)) : (c * SC_T + ia));
            const bf16_t* l1 = T.L1 + (size_t)tok * 768 + (q ? 256 : 0) + 64 * dir + 8 * hi;
#pragma unroll
            for (int s2 = 0; s2 < 4; ++s2) { const bf16x8 af = *(const bf16x8*)(l1 + 16 * s2); acc = MFMA32(af, bfrag[s2], acc); }
            LAS float* dst = (LAS float*)(lds + (q ? SC_BB : SC_W));
#pragma unroll
            for (int r = 0; r < 16; ++r) {
                const float z = acc[r] + bias0; float o;
                if (q == 0) { const float xs = -z; const float sp = fmaxf(xs, 0.f) + logf(1.f + expf(-fabsf(xs))); o = expf(-expf(-sp - 0.5f)); }
                else o = 1.f / (1.f + expf(-z));
                dst[(32 * mt + crow(r, hi)) * 64 + 32 * nt + r32] = o;
            }
        }
        __syncthreads();
        {
            const int tok = tbase + (dir ? (SEQ - 1 - (c * SC_T + bi)) : (c * SC_T + bi));
            const size_t go = (size_t)tok * 1024 + h * 64 + cb;
            const u32x4 kq = *(const u32x4*)(T.K + go), rq = *(const u32x4*)(T.R + go), vq = *(const u32x4*)(T.V + go);
            float kf[8], rf[8], vf[8];
#pragma unroll
            for (int e = 0; e < 4; ++e) { kf[2 * e] = h2f((unsigned short)(kq[e] & 0xffffu)); kf[2 * e + 1] = h2f((unsigned short)(kq[e] >> 16));
                rf[2 * e] = h2f((unsigned short)(rq[e] & 0xffffu)); rf[2 * e + 1] = h2f((unsigned short)(rq[e] >> 16));
                vf[2 * e] = h2f((unsigned short)(vq[e] & 0xffffu)); vf[2 * e + 1] = h2f((unsigned short)(vq[e] >> 16)); }
            LAS float* pw = (LAS float*)(lds + SC_W) + bi * 64 + cb; LAS float* pb = (LAS float*)(lds + SC_BB) + bi * 64 + cb;
            const f32x4 w0v = *(LAS f32x4*)pw, w1v = *(LAS f32x4*)(pw + 4), a0v = *(LAS f32x4*)pb, a1v = *(LAS f32x4*)(pb + 4);
            float kk[8], nn = 0.f;
#pragma unroll
            for (int e = 0; e < 8; ++e) { kk[e] = kf[e] * kkc[e]; nn += kk[e] * kk[e]; }
            nn = red8(nn);
            const float inv = 1.f / fmaxf(sqrtf(nn), 1e-12f);
            float an[8], bb[8], kd[8], wr[8], br = 0.f, kr = 0.f, bon = 0.f;
#pragma unroll
            for (int e = 0; e < 8; ++e) { const float av = (e < 4) ? a0v[e & 3] : a1v[e & 3], wv = (e < 4) ? w0v[e & 3] : w1v[e & 3];
                const float kn = kk[e] * inv; an[e] = -kn; bb[e] = kn * av; kd[e] = kf[e] * (1.f + (av - 1.f) * kac[e]); wr[e] = wv * rf[e];
                br += bb[e] * rf[e]; kr += kd[e] * rf[e]; bon += rf[e] * kd[e] * rkc[e]; }
            br = red8(br); kr = red8(kr); bon = red8(bon);
            LAS float* pa = (LAS float*)(lds + SC_AN) + bi * 64 + cb; LAS float* pr = (LAS float*)(lds + SC_WR) + bi * 64 + cb; LAS float* pk = (LAS float*)(lds + SC_KD) + bi * 64 + cb; LAS float* pv = (LAS float*)(lds + SC_V) + bi * 64 + cb;
            *(LAS f32x4*)pa = (f32x4){an[0], an[1], an[2], an[3]}; *(LAS f32x4*)(pa + 4) = (f32x4){an[4], an[5], an[6], an[7]};
            *(LAS f32x4*)pr = (f32x4){wr[0], wr[1], wr[2], wr[3]}; *(LAS f32x4*)(pr + 4) = (f32x4){wr[4], wr[5], wr[6], wr[7]};
            *(LAS f32x4*)pb = (f32x4){bb[0], bb[1], bb[2], bb[3]}; *(LAS f32x4*)(pb + 4) = (f32x4){bb[4], bb[5], bb[6], bb[7]};
            *(LAS f32x4*)pk = (f32x4){kd[0], kd[1], kd[2], kd[3]}; *(LAS f32x4*)(pk + 4) = (f32x4){kd[4], kd[5], kd[6], kd[7]};
            *(LAS f32x4*)pv = (f32x4){vf[0], vf[1], vf[2], vf[3]}; *(LAS f32x4*)(pv + 4) = (f32x4){vf[4], vf[5], vf[6], vf[7]};
            if ((tid & 7) == 0) { LAS float* sc = (LAS float*)(lds + SC_SCAL) + bi * 2; sc[0] = br; sc[1] = kr; T.BON[((size_t)dir * T.rows + tok) * 16 + h] = bon; }
        }
        __syncthreads();
        {
            const LAS unsigned char* base = lds;
#pragma unroll 2
            for (int i = 0; i < SC_T; ++i) {
                const f32x4 an4 = *(const LAS f32x4*)(base + SC_AN + i * 256 + ks * 16), wr4 = *(const LAS f32x4*)(base + SC_WR + i * 256 + ks * 16);
                const f32x4 w4 = *(const LAS f32x4*)(base + SC_W + i * 256 + ks * 16), bb4 = *(const LAS f32x4*)(base + SC_BB + i * 256 + ks * 16), kd4 = *(const LAS f32x4*)(base + SC_KD + i * 256 + ks * 16);
                const f32x2_t vv = *(const LAS f32x2_t*)(base + SC_V + i * 256 + v0 * 4), sc = *(const LAS f32x2_t*)(base + SC_SCAL + i * 8);
                float s0 = (S0[0] * an4[0] + S0[1] * an4[1]) + (S0[2] * an4[2] + S0[3] * an4[3]);
                float s1 = (S1[0] * an4[0] + S1[1] * an4[1]) + (S1[2] * an4[2] + S1[3] * an4[3]);
                float y0 = (S0[0] * wr4[0] + S0[1] * wr4[1]) + (S0[2] * wr4[2] + S0[3] * wr4[3]);
                float y1 = (S1[0] * wr4[0] + S1[1] * wr4[1]) + (S1[2] * wr4[2] + S1[3] * wr4[3]);
                s0 = red16(s0); s1 = red16(s1); y0 = red16(y0); y1 = red16(y1);
                if (ks == 0) { f32x2_t yo; yo[0] = y0 + s0 * sc[0] + vv[0] * sc[1]; yo[1] = y1 + s1 * sc[0] + vv[1] * sc[1]; *(LAS f32x2_t*)(lds + SC_Y + i * 256 + v0 * 4) = yo; }
                S0 = S0 * w4 + s0 * bb4 + vv[0] * kd4;
                S1 = S1 * w4 + s1 * bb4 + vv[1] * kd4;
            }
        }
        __syncthreads();
        {
            const int tok = tbase + (dir ? (SEQ - 1 - (c * SC_T + bi)) : (c * SC_T + bi));
            const LAS float* py = (const LAS float*)(lds + SC_Y) + bi * 64 + cb;
            const f32x4 a = *(const LAS f32x4*)py, bq = *(const LAS f32x4*)(py + 4);
            u32x4 w; w.x = pk2(a[0], a[1]); w.y = pk2(a[2], a[3]); w.z = pk2(bq[0], bq[1]); w.w = pk2(bq[2], bq[3]);
            *(u32x4*)(T.Y + ((size_t)dir * T.rows + tok) * 1024 + h * 64 + cb) = w;
        }
    }
    __syncthreads();
}
__device__ __forceinline__ void rwkv_scan_phase(LAS unsigned char* lds, const ScanTensors& T, int nbat, int vcu, int G) {
    const int nunits = nbat * 32;
    for (int u = vcu; u < nunits; u += G) { const int dir = u & 1, h = (u >> 1) & 15, b = u >> 5; rwkv_scan_unit(lds, T, b, h, dir); }
}
__device__ __forceinline__ void rwkv_post_phase(const bf16_t* Y, const float* BON, const unsigned short* V, const bf16_t* Gt, const float* lnw, const float* lnb, bf16_t* POST, int rows, int gw, int ngw, int lane) {
    const long n = (long)rows * 16;
    for (long it = gw; it < n; it += ngw) {
        const int tok = (int)(it >> 4), h = (int)(it & 15), c = h * 64 + lane; const size_t o = (size_t)tok * 1024 + c;
        const float yv = bf2f(Y[o]) + bf2f(Y[(size_t)rows * 1024 + o]);
        const float mean = wave_sum(yv) * (1.f / 64.f), dv = yv - mean, var = wave_sum(dv * dv) * (1.f / 64.f);
        const float yn = dv * rsqrtf(var + 64e-5f) * lnw[c] + lnb[c];
        const float bon = BON[(size_t)tok * 16 + h] + BON[((size_t)rows + tok) * 16 + h];
        POST[o] = (bf16_t)f2bf((yn + bon * h2f(V[o])) * bf2f(Gt[o]));
    }
}

constexpr size_t SW_QKV = WS_SCR, SW_QP = WS_SCR + 48 * MiB, SW_KP = WS_SCR + 80 * MiB, SW_VT = WS_SCR + 88 * MiB, SW_O = WS_SCR + 96 * MiB;
constexpr size_t ML_DOWN = WS_SCR, ML_Q = WS_SCR + 24 * MiB, ML_KV = WS_SCR + 72 * MiB, ML_KP = WS_SCR + 136 * MiB, ML_VT = WS_SCR + 184 * MiB, ML_O = WS_SCR + 216 * MiB;
constexpr size_t RW_HX = WS_SCR, RW_Y = WS_SCR, RW_R = WS_SCR + 64 * MiB, RW_K = WS_SCR + 96 * MiB, RW_V = WS_SCR + 128 * MiB, RW_L1 = WS_SCR + 160 * MiB, RW_G = WS_SCR + 184 * MiB, RW_POST = WS_SCR + 216 * MiB, RW_BON = WS_SCR + 248 * MiB;
static_assert(ML_O + 32 * MiB <= WS_END && RW_BON + 2 * MiB <= WS_END, "scratch map");

#define GRID_SYNC() grid.sync()
#define PH_BEGIN() const int L = opaque_s(layer); (void)L; unsigned char* ws = P.ws; asm volatile("" : "+s"(ws)); const int tid = opaque_tid(), lane = tid & 63, wave = __builtin_amdgcn_readfirstlane(tid >> 6); (void)lane; (void)wave; \
    const int G = opaque_s((int)gridDim.x), bx = opaque_s((int)blockIdx.x), gw = bx * 8 + wave, ngw = G * 8, gtid = bx * 512 + tid, ngt = G * 512, vcu = (bx % 8) * (G / 8) + bx / 8; (void)gw; (void)ngw; (void)gtid; (void)ngt; (void)vcu; \
    const int kind = L % 3, jj = L / 3; (void)kind; (void)jj; \
    bf16_t* XB = (bf16_t*)(ws + WS_XB); float* SSP = (float*)(ws + WS_SSP); float* SSP2 = (float*)(ws + WS_SSP2); const float* rope = (const float*)(ws + WS_ROPE); (void)XB; (void)SSP; (void)SSP2; (void)rope; \
    const RowScale rsx{SSP, 16, 0, 16, 1.f / 1024.f}; (void)rsx;

__global__ void __launch_bounds__(512, 2) mega_fwd(Params P) {
    extern __shared__ __attribute__((aligned(16))) unsigned char lds_raw[];
    LAS unsigned char* lds = (LAS unsigned char*)lds_raw;
    cg::grid_group grid = cg::this_grid();

    { const int layer = 0; PH_BEGIN();
      rope_phase((float*)(ws + WS_ROPE), gtid, ngt);
#pragma unroll 1
      for (int l2 = 0; l2 < DEPTH; ++l2) mixer_weights_phase(P, l2, lds, gw, ngw, wave, lane);
      ffn_weights_phase(P, 0, lds, gw, ngw, wave, lane);
      rownorm_phase(P.in[0], XB, SSP, MTOK, gw, ngw, lane); }
    GRID_SYNC();

#pragma unroll 1
    for (int layer = 0; layer < DEPTH; ++layer) {
        if (layer > 0) { PH_BEGIN(); ffn_weights_phase(P, L, lds, gw, ngw, wave, lane); __syncthreads(); }
        if (layer % 3 == 0) {
            { PH_BEGIN(); pg8::Gemm g{XB, (const bf16_t*)(ws + (jj ? WM_QKV1 : WM_QKV0)), MTOK, 1536, 1024, 1024, 1024}; pg8::StaticOrder S; S.init(MTOK, 1536, G, bx);
              EpiScaleBf16 E{(bf16_t*)(ws + SW_QKV), 1536, rsx, nullptr, 0};
              pg8::gemm_phase<EpiScaleBf16, pg8::StaticOrder, true, true>(lds, g, S, E); }
            GRID_SYNC();
            { PH_BEGIN(); swa_prep_phase((const bf16_t*)(ws + SW_QKV), P.in[8] + jj * 64, P.in[9] + jj * 64, rope, rope + SEQ * 8, (bf16_t*)(ws + SW_QP), (bf16_t*)(ws + SW_KP), (bf16_t*)(ws + SW_VT), MTOK, gw, ngw, lane); }
            GRID_SYNC();
            { PH_BEGIN(); swa_attn_phase(lds, (const bf16_t*)(ws + SW_QP), (const bf16_t*)(ws + SW_KP), (const bf16_t*)(ws + SW_VT), P.in[10] + jj * 16, (bf16_t*)(ws + SW_O), BATCH, vcu, G, wave); }
            GRID_SYNC();
        } else if (layer % 3 == 1) {
            { PH_BEGIN(); rwkv_premix_phase(P.out, SSP, P.in[1] + L * DM, (bf16_t*)(ws + RW_HX), MTOK, gw, ngw, lane); }
            GRID_SYNC();
            { PH_BEGIN(); pg8::Gemm g{(const bf16_t*)(ws + RW_HX), (const bf16_t*)(ws + WM_BIG), MTOK, 3840, 2048, 2048, 2048}; pg8::StaticOrder S; S.init(MTOK, 3840, G, bx);
              EpiRwkvBig E{(unsigned short*)(ws + RW_R), (RW_K - RW_R) / 2, (bf16_t*)(ws + RW_L1)};
              pg8::gemm_phase<EpiRwkvBig, pg8::StaticOrder, true, true>(lds, g, S, E); }
            GRID_SYNC();
            { PH_BEGIN(); pg8::Gemm g{(const bf16_t*)(ws + RW_L1) + 512, (const bf16_t*)(ws + WM_G2), MTOK, 1024, 256, 768, 256}; pg8::StaticOrder S; S.init(MTOK, 1024, G, bx);
              EpiScaleBf16 E{(bf16_t*)(ws + RW_G), 1024, RowScale{nullptr, 0, 0, 0, 0.f}, nullptr, 0};
              pg8::gemm_phase<EpiScaleBf16, pg8::StaticOrder, true, true>(lds, g, S, E); }
            __syncthreads();
            { PH_BEGIN(); ScanTensors T{(const unsigned short*)(ws + RW_R), (const unsigned short*)(ws + RW_K), (const unsigned short*)(ws + RW_V), (const bf16_t*)(ws + RW_L1),
                            (const bf16_t*)(ws + WM_W2T), (const bf16_t*)(ws + WM_A2T), P.in[16], P.in[19], P.in[24], P.in[25], P.in[26], (bf16_t*)(ws + RW_Y), (float*)(ws + RW_BON), MTOK};
              rwkv_scan_phase(lds, T, BATCH, vcu, G); }
            GRID_SYNC();
            { PH_BEGIN(); rwkv_post_phase((const bf16_t*)(ws + RW_Y), (const float*)(ws + RW_BON), (const unsigned short*)(ws + RW_V), (const bf16_t*)(ws + RW_G), P.in[27], P.in[28], (bf16_t*)(ws + RW_POST), MTOK, gw, ngw, lane); }
            GRID_SYNC();
        } else {
            { PH_BEGIN(); pg8::Gemm g{XB, (const bf16_t*)(ws + WM_DOWN), MTOK, 768, 1024, 1024, 1024}; pg8::StaticOrder S; S.init(MTOK, 768, G, bx);
              EpiScaleBf16 E{(bf16_t*)(ws + ML_DOWN), 768, rsx, SSP2, 24};
              pg8::gemm_phase<EpiScaleBf16, pg8::StaticOrder, true, true>(lds, g, S, E); }
            GRID_SYNC();
            { PH_BEGIN(); pg8::Gemm g{(const bf16_t*)(ws + ML_DOWN), (const bf16_t*)(ws + WM_UQ), MTOK, 1536, 384, 768, 384}; pg8::StaticOrder S; S.init(MTOK, 1536, G, bx);
              EpiScaleBf16 E{(bf16_t*)(ws + ML_Q), 1536, RowScale{SSP2, 24, 0, 12, 1.f / 384.f}, nullptr, 0};
              pg8::gemm_phase<EpiScaleBf16, pg8::StaticOrder, true, true>(lds, g, S, E); }
            __syncthreads();
            { PH_BEGIN(); pg8::Gemm g{(const bf16_t*)(ws + ML_DOWN) + 512, (const bf16_t*)(ws + WM_UKV), MTOK, 2048, 256, 768, 256}; pg8::StaticOrder S; S.init(MTOK, 2048, G, bx);
              EpiScaleBf16 E{(bf16_t*)(ws + ML_KV), 2048, RowScale{SSP2, 24, 16, 8, 1.f / 256.f}, nullptr, 0};
              pg8::gemm_phase<EpiScaleBf16, pg8::StaticOrder, true, true>(lds, g, S, E); }
            GRID_SYNC();
            { PH_BEGIN(); mla_prep_phase((bf16_t*)(ws + ML_Q), (const bf16_t*)(ws + ML_KV), (const bf16_t*)(ws + ML_DOWN), P.in[35], P.in[36], rope + SEQ * 16, rope + SEQ * 32, (bf16_t*)(ws + ML_KP), (bf16_t*)(ws + ML_VT), MTOK, gw, ngw, lane); }
            GRID_SYNC();
            { PH_BEGIN(); mla_attn_phase(lds, (const bf16_t*)(ws + ML_Q), (const bf16_t*)(ws + ML_KP), (const bf16_t*)(ws + ML_VT), (bf16_t*)(ws + ML_O), BATCH, vcu, G, wave); }
            GRID_SYNC();
        }
        { PH_BEGIN(); const size_t o_off = kind == 0 ? SW_O : (kind == 1 ? RW_POST : ML_O), wo_off = kind == 0 ? (jj ? WM_OA1 : WM_OA0) : (kind == 1 ? WM_OB : WM_OC);
          pg8::Gemm g{(const bf16_t*)(ws + o_off), (const bf16_t*)(ws + wo_off), MTOK, 1024, 1024, 1024, 1024}; pg8::StaticOrder S; S.init(MTOK, 1024, G, bx);
          EpiResid E{(L == 0) ? P.in[0] : P.out, P.out, XB, SSP};
          pg8::gemm_phase<EpiResid, pg8::StaticOrder, true, true>(lds, g, S, E); }
        GRID_SYNC();
        { PH_BEGIN(); pg8::Gemm g{XB, (const bf16_t*)(ws + WS_WUP), MTOK, FF2, 1024, 1024, 1024}; pg8::StaticOrder S; S.init(MTOK, FF2, G, bx);
          EpiScaleBf16 E{(bf16_t*)(ws + WS_U), FF2, rsx, nullptr, 0};
          pg8::gemm_phase<EpiScaleBf16, pg8::StaticOrder, true, true>(lds, g, S, E); }
        GRID_SYNC();
        { PH_BEGIN(); ffn_conv_phase((const bf16_t*)(ws + WS_U), P.in[4] + (size_t)L * 3 * FF2, P.in[5] + (size_t)L * FF2, (bf16_t*)(ws + WS_ACT), MTOK, gtid, ngt); }
        GRID_SYNC();
        { PH_BEGIN(); pg8::Gemm g{(const bf16_t*)(ws + WS_ACT), (const bf16_t*)(ws + WS_WDN), MTOK, 1024, FFN, FFN, FFN}; pg8::StaticOrder S; S.init(MTOK, 1024, G, bx);
          EpiResid E{P.out, P.out, XB, SSP};
          pg8::gemm_phase<EpiResid, pg8::StaticOrder, true, true>(lds, g, S, E); }
        if (layer + 1 < DEPTH) GRID_SYNC();
    }
}

extern "C" void kernel_launch(void* const* d_in, const int* in_sizes, int n_in, void* d_out, int out_size, void* d_ws, size_t ws_size, hipStream_t stream) {
    static int grid = 0;
    if (grid == 0) {
        if (n_in != 38 || out_size != BATCH * SEQ * DM || ws_size < WS_END) { fprintf(stderr, "kernel_launch: unexpected shapes / workspace (%d inputs, out %d, ws %zu)\n", n_in, out_size, ws_size); grid = -1; return; }
        int dev = 0, cus = 0, per_cu = 0;
        if (hipGetDevice(&dev) != hipSuccess || hipDeviceGetAttribute(&cus, hipDeviceAttributeMultiprocessorCount, dev) != hipSuccess) { grid = -1; return; }
        if (hipFuncSetAttribute((const void*)mega_fwd, hipFuncAttributeMaxDynamicSharedMemorySize, LDS_BYTES) != hipSuccess) { fprintf(stderr, "kernel_launch: hipFuncSetAttribute failed\n"); grid = -1; return; }
        if (hipOccupancyMaxActiveBlocksPerMultiprocessor(&per_cu, (const void*)mega_fwd, 512, LDS_BYTES) != hipSuccess || per_cu < 1) { fprintf(stderr, "kernel_launch: occupancy query says %d blocks per CU\n", per_cu); (void)hipGetLastError(); grid = -1; return; }
        grid = cus;
    }
    if (grid < 0) return;
    Params P{};
    for (int i = 0; i < 38; ++i) P.in[i] = (const float*)d_in[i];
    P.out = (float*)d_out; P.ws = (unsigned char*)d_ws;
    void* args[] = {&P};
    hipError_t e = hipLaunchCooperativeKernel((const void*)mega_fwd, dim3(grid), dim3(512), args, LDS_BYTES, stream);
    if (e != hipSuccess) fprintf(stderr, "kernel_launch: cooperative launch failed: %s (grid %d)\n", hipGetErrorString(e), grid);
}
```
